# Optimizing an MI355X kernel written in HIP

```python
import math
import jax
import jax.numpy as jnp
from jax import lax
import numpy as np

D_MODEL = 2048
BATCH = 8
SEQ = 2048
DEPTH = 2

MEM_LEN = 256
EPS = 1e-6
ROPE_THETA = 10000.0
Q_BLOCK = 128
NEG_INF = -1e30
HEAD_DIM = 64

SWA_HEADS = 16
SWA_KV_HEADS = 4
SWA_WINDOW = 128
SWA_Q_W = SWA_HEADS * HEAD_DIM
SWA_KV_W = SWA_KV_HEADS * HEAD_DIM

RWKV_HEADS = 16
RWKV_HEAD = 64
RWKV_DIM = RWKV_HEADS * RWKV_HEAD
DECAY_LORA = 64
AAA_LORA = 64
GATE_LORA = 160
RWKV_GN_EPS = 64e-5
RWKV_W = 3 * RWKV_DIM + DECAY_LORA + AAA_LORA + GATE_LORA

MLA_HEADS = 16
MLA_Q_RANK = 512
MLA_KV_RANK = 256
MLA_NOPE = 64
MLA_ROPE = 32
MLA_V = 64

DIFF_HEADS = 8
DIFF_QK = 64
DIFF_V = 2 * DIFF_QK

MEM_HEADS = 4
MEM_HEAD_DIM = 128
MEM_W = MEM_HEADS * MEM_HEAD_DIM

D_FF = 5632

AB_IN = SWA_Q_W + 2 * SWA_KV_W + RWKV_W
AB_OUT = SWA_Q_W + RWKV_DIM
CD_IN = MLA_Q_RANK + MLA_KV_RANK + MLA_ROPE + 2 * (DIFF_HEADS * 2 * DIFF_QK) + DIFF_HEADS * DIFF_V
CD_OUT = MLA_HEADS * MLA_V + DIFF_HEADS * DIFF_V
N_EVEN = (DEPTH + 1) // 2
N_ODD = DEPTH // 2

kernel_name = 'hybrid_swa_rwkv7_mla_diff_macaron'


def rms_norm(x, g):
    xf = x.astype(jnp.float32)
    y = xf * lax.rsqrt(jnp.mean(xf * xf, axis=-1, keepdims=True) + EPS)
    return (y * g.astype(jnp.float32)).astype(x.dtype)


def rope_tables(positions, dim):
    inv = 1.0 / (ROPE_THETA ** (jnp.arange(0, dim, 2, dtype=jnp.float32) / dim))
    ang = positions.astype(jnp.float32)[..., None] * inv
    return jnp.cos(ang), jnp.sin(ang)


def apply_rope(x, cos, sin):
    x1, x2 = jnp.split(x.astype(jnp.float32), 2, axis=-1)
    c = cos[:, :, None, :]
    s = sin[:, :, None, :]
    return jnp.concatenate([x1 * c - x2 * s, x1 * s + x2 * c], axis=-1).astype(x.dtype)


def swiglu(h, w_gate, w_up, w_down):
    return (jax.nn.silu(h @ w_gate) * (h @ w_up)) @ w_down


def sliding_window_sink_attention(q, k, v, sinks):
    B, S, H, d = q.shape
    KV = k.shape[2]
    G = H // KV
    nb = S // Q_BLOCK
    qb = q.reshape(B, nb, Q_BLOCK, KV, G, d)

    def with_prev(t):
        t = t.reshape(B, nb, Q_BLOCK, KV, d)
        prev = jnp.concatenate([jnp.zeros_like(t[:, :1]), t[:, :-1]], axis=1)
        return jnp.concatenate([prev, t], axis=2)

    kk, vv = with_prev(k), with_prev(v)
    s = jnp.einsum('bnqkgd,bnskd->bnkgqs', qb, kk).astype(jnp.float32) * (d ** -0.5)
    k_idx = jnp.arange(2 * Q_BLOCK)[None, :]
    rel = (jnp.arange(Q_BLOCK)[:, None] + Q_BLOCK) - k_idx
    band = (rel >= 0) & (rel < SWA_WINDOW)
    blk_ok = (jnp.arange(nb)[:, None, None] > 0) | (k_idx[None] >= Q_BLOCK)
    valid = (band[None] & blk_ok)[None, :, None, None]
    s = jnp.where(valid, s, NEG_INF)
    sink = sinks.astype(jnp.float32).reshape(1, 1, KV, G, 1, 1)
    m = jnp.maximum(jnp.max(s, axis=-1, keepdims=True), sink)
    p = jnp.exp(s - m)
    p = p / (jnp.sum(p, axis=-1, keepdims=True) + jnp.exp(sink - m))
    o = jnp.einsum('bnkgqs,bnskd->bnqkgd', p.astype(v.dtype), vv)
    return o.reshape(B, S, H, d)


def rwkv7_time_mix(proj, mu, w0, w2, a0, a2, g2, k_k, k_a, r_k, gn_g, gn_b):
    B, S, _ = proj.shape
    f32 = jnp.float32
    p = proj.astype(f32)
    prev = jnp.concatenate([jnp.zeros_like(p[:, :1]), p[:, :-1]], axis=1)
    xs = p + (prev - p) * mu.astype(f32)
    c3 = 3 * RWKV_DIM
    r, k, v, w_lo, a_lo, g_lo = jnp.split(
        xs, [RWKV_DIM, 2 * RWKV_DIM, c3, c3 + DECAY_LORA, c3 + DECAY_LORA + AAA_LORA], axis=-1)
    w = -jax.nn.softplus(-(w0.astype(f32) + jnp.tanh(w_lo) @ w2.astype(f32))) - 0.5
    a = jax.nn.sigmoid(a0.astype(f32) + a_lo @ a2.astype(f32))
    g = jax.nn.sigmoid(g_lo) @ g2.astype(f32)
    hs = (B, S, RWKV_HEADS, RWKV_HEAD)
    r, k, v, w, a = r.reshape(hs), k.reshape(hs), v.reshape(hs), w.reshape(hs), a.reshape(hs)
    kk = k * k_k.astype(f32).reshape(RWKV_HEADS, RWKV_HEAD)
    kk = kk / jnp.maximum(jnp.sqrt(jnp.sum(kk * kk, axis=-1, keepdims=True)), 1e-12)
    k = k * (1.0 + (a - 1.0) * k_a.astype(f32).reshape(RWKV_HEADS, RWKV_HEAD))
    decay = jnp.exp(-jnp.exp(w))

    def step(state, inp):
        r_t, k_t, v_t, d_t, kk_t, a_t = inp
        sa = jnp.einsum('bhij,bhj->bhi', state, -kk_t)
        state = (state * d_t[:, :, None, :] + sa[..., None] * (kk_t * a_t)[:, :, None, :]
                 + v_t[..., None] * k_t[:, :, None, :])
        return state, jnp.einsum('bhij,bhj->bhi', state, r_t)

    sf = lambda t: jnp.swapaxes(t, 0, 1)
    init = jnp.zeros((B, RWKV_HEADS, RWKV_HEAD, RWKV_HEAD), f32)
    _, y = lax.scan(step, init, (sf(r), sf(k), sf(v), sf(decay), sf(kk), sf(a)))
    y = sf(y)
    mean = jnp.mean(y, axis=-1, keepdims=True)
    var = jnp.mean(jnp.square(y - mean), axis=-1, keepdims=True)
    y = ((y - mean) * lax.rsqrt(var + RWKV_GN_EPS)).reshape(B, S, RWKV_DIM) * gn_g.astype(f32) + gn_b.astype(f32)
    bonus = jnp.sum(r * k * r_k.astype(f32).reshape(RWKV_HEADS, RWKV_HEAD), axis=-1, keepdims=True) * v
    out = (y + bonus.reshape(B, S, RWKV_DIM)) * g
    return out.astype(proj.dtype)


def causal_block_probs(q_blk, k, q_start):
    s = jnp.einsum('bqhd,bshd->bhqs', q_blk, k).astype(jnp.float32)
    q_pos = q_start + jnp.arange(Q_BLOCK)
    mask = jnp.arange(k.shape[1])[None, :] <= q_pos[:, None]
    return jax.nn.softmax(jnp.where(mask, s, NEG_INF), axis=-1)


def causal_block_attention(q, k, v, scale):
    B, S, H, d = q.shape
    nb = S // Q_BLOCK
    qb = jnp.swapaxes((q * scale).reshape(B, nb, Q_BLOCK, H, d), 0, 1)

    def one(args):
        i, q_blk = args
        p = causal_block_probs(q_blk, k, i * Q_BLOCK)
        return jnp.einsum('bhqs,bshd->bqhd', p.astype(v.dtype), v)

    o = lax.map(one, (jnp.arange(nb), qb))
    return jnp.swapaxes(o, 0, 1).reshape(B, S, H, v.shape[-1])


def mla_attention(c_q, c_kv, k_pe, cq_norm, ckv_norm, w_uq, w_ukv,
                  q_nope_norm, k_nope_norm, q_rope_norm, k_rope_norm, cos, sin):
    B, S, _ = c_q.shape
    q = (rms_norm(c_q, cq_norm) @ w_uq).reshape(B, S, MLA_HEADS, MLA_NOPE + MLA_ROPE)
    kv = (rms_norm(c_kv, ckv_norm) @ w_ukv).reshape(B, S, MLA_HEADS, MLA_NOPE + MLA_V)
    q_nope, q_pe = jnp.split(q, [MLA_NOPE], axis=-1)
    k_nope, v = jnp.split(kv, [MLA_NOPE], axis=-1)
    q_nope = rms_norm(q_nope, q_nope_norm)
    k_nope = rms_norm(k_nope, k_nope_norm)
    q_pe = apply_rope(rms_norm(q_pe, q_rope_norm), cos, sin)
    k_pe = apply_rope(rms_norm(k_pe.reshape(B, S, 1, MLA_ROPE), k_rope_norm), cos, sin)
    q = jnp.concatenate([q_nope, q_pe], axis=-1)
    k = jnp.concatenate([k_nope, jnp.broadcast_to(k_pe, (B, S, MLA_HEADS, MLA_ROPE))], axis=-1)
    o = causal_block_attention(q, k, v, (MLA_NOPE + MLA_ROPE) ** -0.5)
    return o.reshape(B, S, MLA_HEADS * MLA_V)


def differential_attention(dq, dk, dv, q_norm, k_norm, lq1, lk1, lq2, lk2, subln, lambda_init, cos, sin):
    B, S, _ = dq.shape
    f32 = jnp.float32
    q = apply_rope(rms_norm(dq.reshape(B, S, 2 * DIFF_HEADS, DIFF_QK), q_norm), cos, sin) * (DIFF_QK ** -0.5)
    k = apply_rope(rms_norm(dk.reshape(B, S, 2 * DIFF_HEADS, DIFF_QK), k_norm), cos, sin)
    q = q.reshape(B, S, DIFF_HEADS, 2, DIFF_QK)
    k = k.reshape(B, S, DIFF_HEADS, 2, DIFF_QK)
    k1, k2 = k[:, :, :, 0], k[:, :, :, 1]
    v = dv.reshape(B, S, DIFF_HEADS, DIFF_V)
    lam = (jnp.exp(jnp.sum(lq1.astype(f32) * lk1.astype(f32)))
           - jnp.exp(jnp.sum(lq2.astype(f32) * lk2.astype(f32))) + lambda_init)
    nb = S // Q_BLOCK
    qb = jnp.swapaxes(q.reshape(B, nb, Q_BLOCK, DIFF_HEADS, 2, DIFF_QK), 0, 1)

    def one(args):
        i, q_blk = args
        p1 = causal_block_probs(q_blk[:, :, :, 0], k1, i * Q_BLOCK)
        p2 = causal_block_probs(q_blk[:, :, :, 1], k2, i * Q_BLOCK)
        return jnp.einsum('bhqs,bshd->bqhd', (p1 - lam * p2).astype(v.dtype), v)

    o = jnp.swapaxes(lax.map(one, (jnp.arange(nb), qb)), 0, 1).reshape(B, S, DIFF_HEADS, DIFF_V)
    o = rms_norm(o, subln) * (1.0 - lambda_init)
    return o.reshape(B, S, DIFF_HEADS * DIFF_V)


def memory_cross_attention(h, mem_k, mem_v, w_q, q_norm, w_o):
    B, S, _ = h.shape
    q = rms_norm((h @ w_q).reshape(B, S, MEM_HEADS, MEM_HEAD_DIM), q_norm)
    s = jnp.einsum('bshd,bmhd->bhsm', q, mem_k).astype(jnp.float32) * (MEM_HEAD_DIM ** -0.5)
    p = jax.nn.softmax(s, axis=-1)
    o = jnp.einsum('bhsm,bmhd->bshd', p.astype(mem_v.dtype), mem_v).reshape(B, S, MEM_W)
    return o @ w_o


def setup_inputs(seed: int = 0) -> dict:
    key = jax.random.key(seed)
    ks = iter(jax.random.split(key, 64))
    f32 = jnp.float32

    def normal(shape, scale):
        return jax.random.normal(next(ks), shape, f32) * scale

    def gain(shape):
        return 1.0 + 0.02 * jax.random.normal(next(ks), shape, f32)

    D, F, E, O = D_MODEL, D_FF, N_EVEN, N_ODD
    x = normal((BATCH, SEQ, D), 1.0)
    mem = normal((BATCH, MEM_LEN, D), 1.0)
    positions = (jax.random.randint(next(ks), (BATCH, 1), 0, 4096) + jnp.arange(SEQ)[None, :]).astype(jnp.int32)
    return {
        'x': x, 'mem': mem, 'positions': positions,
        'ffn1_norm': gain((DEPTH, D)),
        'ffn1_w_gate': normal((DEPTH, D, F), D ** -0.5),
        'ffn1_w_up': normal((DEPTH, D, F), D ** -0.5),
        'ffn1_w_down': normal((DEPTH, F, D), F ** -0.5),
        'mix_norm': gain((DEPTH, D)),
        'ab_w_in': normal((E, D, AB_IN), D ** -0.5),
        'ab_w_out': normal((E, AB_OUT, D), AB_OUT ** -0.5),
        'swa_q_norm': gain((E, HEAD_DIM)),
        'swa_k_norm': gain((E, HEAD_DIM)),
        'swa_sinks': normal((E, SWA_HEADS), 1.0),
        'rwkv_mu': jax.random.uniform(next(ks), (E, RWKV_W), f32),
        'rwkv_w0': jax.random.uniform(next(ks), (E, RWKV_DIM), f32, -6.0, -1.0),
        'rwkv_w2': normal((E, DECAY_LORA, RWKV_DIM), 0.5 * DECAY_LORA ** -0.5),
        'rwkv_a0': normal((E, RWKV_DIM), 0.1),
        'rwkv_a2': normal((E, AAA_LORA, RWKV_DIM), AAA_LORA ** -0.5),
        'rwkv_g2': normal((E, GATE_LORA, RWKV_DIM), GATE_LORA ** -0.5),
        'rwkv_k_k': 0.85 + normal((E, RWKV_DIM), 0.02),
        'rwkv_k_a': gain((E, RWKV_DIM)),
        'rwkv_r_k': normal((E, RWKV_DIM), 0.1),
        'rwkv_gn_g': gain((E, RWKV_DIM)),
        'rwkv_gn_b': normal((E, RWKV_DIM), 0.01),
        'cd_w_in': normal((O, D, CD_IN), D ** -0.5),
        'cd_w_out': normal((O, CD_OUT, D), CD_OUT ** -0.5),
        'mla_cq_norm': gain((O, MLA_Q_RANK)),
        'mla_ckv_norm': gain((O, MLA_KV_RANK)),
        'mla_w_uq': normal((O, MLA_Q_RANK, MLA_HEADS * (MLA_NOPE + MLA_ROPE)), MLA_Q_RANK ** -0.5),
        'mla_w_ukv': normal((O, MLA_KV_RANK, MLA_HEADS * (MLA_NOPE + MLA_V)), MLA_KV_RANK ** -0.5),
        'mla_q_nope_norm': gain((O, MLA_NOPE)),
        'mla_k_nope_norm': gain((O, MLA_NOPE)),
        'mla_q_rope_norm': gain((O, MLA_ROPE)),
        'mla_k_rope_norm': gain((O, MLA_ROPE)),
        'diff_q_norm': gain((O, DIFF_QK)),
        'diff_k_norm': gain((O, DIFF_QK)),
        'diff_lq1': normal((O, DIFF_QK), 0.1),
        'diff_lk1': normal((O, DIFF_QK), 0.1),
        'diff_lq2': normal((O, DIFF_QK), 0.1),
        'diff_lk2': normal((O, DIFF_QK), 0.1),
        'diff_subln': gain((O, DIFF_V)),
        'memx_norm': gain((DEPTH, D)),
        'memx_w_q': normal((DEPTH, D, MEM_W), D ** -0.5),
        'memx_q_norm': gain((DEPTH, MEM_HEAD_DIM)),
        'memx_w_o': normal((DEPTH, MEM_W, D), MEM_W ** -0.5),
        'mem_norm': gain((D,)),
        'mem_w_kv': normal((D, 2 * MEM_W), D ** -0.5),
        'mem_k_norm': gain((MEM_HEAD_DIM,)),
        'ffn2_norm': gain((DEPTH, D)),
        'ffn2_w_gate': normal((DEPTH, D, F), D ** -0.5),
        'ffn2_w_up': normal((DEPTH, D, F), D ** -0.5),
        'ffn2_w_down': normal((DEPTH, F, D), F ** -0.5),
    }


def reference(x, mem, positions, ffn1_norm, ffn1_w_gate, ffn1_w_up, ffn1_w_down, mix_norm,
              ab_w_in, ab_w_out, swa_q_norm, swa_k_norm, swa_sinks,
              rwkv_mu, rwkv_w0, rwkv_w2, rwkv_a0, rwkv_a2, rwkv_g2, rwkv_k_k, rwkv_k_a, rwkv_r_k,
              rwkv_gn_g, rwkv_gn_b,
              cd_w_in, cd_w_out, mla_cq_norm, mla_ckv_norm, mla_w_uq, mla_w_ukv,
              mla_q_nope_norm, mla_k_nope_norm, mla_q_rope_norm, mla_k_rope_norm,
              diff_q_norm, diff_k_norm, diff_lq1, diff_lk1, diff_lq2, diff_lk2, diff_subln,
              memx_norm, memx_w_q, memx_q_norm, memx_w_o, mem_norm, mem_w_kv, mem_k_norm,
              ffn2_norm, ffn2_w_gate, ffn2_w_up, ffn2_w_down):
    B, S, _ = x.shape
    M = mem.shape[1]
    cos64, sin64 = rope_tables(positions, HEAD_DIM)
    cos32, sin32 = rope_tables(positions, MLA_ROPE)

    mem_k, mem_v = jnp.split(rms_norm(mem, mem_norm) @ mem_w_kv, 2, axis=-1)
    mem_k = rms_norm(mem_k.reshape(B, M, MEM_HEADS, MEM_HEAD_DIM), mem_k_norm)
    mem_v = mem_v.reshape(B, M, MEM_HEADS, MEM_HEAD_DIM)

    ab_split = [SWA_Q_W, SWA_Q_W + SWA_KV_W, SWA_Q_W + 2 * SWA_KV_W]
    c1 = MLA_Q_RANK
    c2 = c1 + MLA_KV_RANK
    c3 = c2 + MLA_ROPE
    c4 = c3 + DIFF_HEADS * 2 * DIFF_QK
    c5 = c4 + DIFF_HEADS * 2 * DIFF_QK
    cd_split = [c1, c2, c3, c4, c5]

    for layer in range(DEPTH):
        x = x + 0.5 * swiglu(rms_norm(x, ffn1_norm[layer]), ffn1_w_gate[layer], ffn1_w_up[layer], ffn1_w_down[layer])
        h = rms_norm(x, mix_norm[layer])
        j = layer // 2
        if layer % 2 == 0:
            u = h @ ab_w_in[j]
            qa, ka, va, rw = jnp.split(u, ab_split, axis=-1)
            q = apply_rope(rms_norm(qa.reshape(B, S, SWA_HEADS, HEAD_DIM), swa_q_norm[j]), cos64, sin64)
            k = apply_rope(rms_norm(ka.reshape(B, S, SWA_KV_HEADS, HEAD_DIM), swa_k_norm[j]), cos64, sin64)
            v = va.reshape(B, S, SWA_KV_HEADS, HEAD_DIM)
            y_a = sliding_window_sink_attention(q, k, v, swa_sinks[j]).reshape(B, S, SWA_Q_W)
            y_b = rwkv7_time_mix(rw, rwkv_mu[j], rwkv_w0[j], rwkv_w2[j], rwkv_a0[j], rwkv_a2[j], rwkv_g2[j],
                                 rwkv_k_k[j], rwkv_k_a[j], rwkv_r_k[j], rwkv_gn_g[j], rwkv_gn_b[j])
            mixed = jnp.concatenate([y_a, y_b], axis=-1) @ ab_w_out[j]
        else:
            u = h @ cd_w_in[j]
            c_q, c_kv, k_pe, dq, dk, dv = jnp.split(u, cd_split, axis=-1)
            y_c = mla_attention(c_q, c_kv, k_pe, mla_cq_norm[j], mla_ckv_norm[j], mla_w_uq[j], mla_w_ukv[j],
                                mla_q_nope_norm[j], mla_k_nope_norm[j], mla_q_rope_norm[j], mla_k_rope_norm[j],
                                cos32, sin32)
            lambda_init = 0.8 - 0.6 * math.exp(-0.3 * layer)
            y_d = differential_attention(dq, dk, dv, diff_q_norm[j], diff_k_norm[j], diff_lq1[j], diff_lk1[j],
                                         diff_lq2[j], diff_lk2[j], diff_subln[j], lambda_init, cos64, sin64)
            mixed = jnp.concatenate([y_c, y_d], axis=-1) @ cd_w_out[j]
        x = x + mixed
        x = x + memory_cross_attention(rms_norm(x, memx_norm[layer]), mem_k, mem_v,
                                       memx_w_q[layer], memx_q_norm[layer], memx_w_o[layer])
        x = x + 0.5 * swiglu(rms_norm(x, ffn2_norm[layer]), ffn2_w_gate[layer], ffn2_w_up[layer], ffn2_w_down[layer])
    return x
```

```cpp
#include <hip/hip_runtime.h>
#include <hip/hip_cooperative_groups.h>
#include <cstdio>
#include <cstdint>
#include <cmath>
namespace cg = cooperative_groups;
namespace pg8 {
#define PG8_LAS __attribute__((address_space(3)))
typedef unsigned short bf16_t;
typedef short bf16x8 __attribute__((ext_vector_type(8)));
typedef float f32x4 __attribute__((ext_vector_type(4)));
typedef unsigned u32x4 __attribute__((ext_vector_type(4)));
constexpr int BM = 256, BK = 64, HALF = 128, HTB = HALF * BK * 2  , STAGE_BYTES = 8 * HTB, NXCD = 8, WGM = 8;

__host__ __device__ __forceinline__ int lds_byte(int r, int c) { const int st = (r >> 4) * 2 + (c >> 5), rr = r & 15, cc = c & 31, ob = rr * 64 + cc * 2; return st * 1024 + (ob ^ (((ob >> 9) & 1) << 5)); }
__host__ __device__ __forceinline__ void stage_rc(int b, int& R, int& C) { const int st = b / 1024, sb = b % 1024, swz = sb ^ (((sb >> 9) & 1) << 5); R = (st >> 1) * 16 + swz / 64; C = (st & 1) * 32 + (swz % 64) / 2; }
__host__ __device__ __forceinline__ int perm32(int rho) { const int n = rho >> 4, i = rho & 15; return 8 * (i >> 2) + 4 * n + (i & 3); }

struct Unit { int pm, pn; };
struct Gemm { const bf16_t* A; const bf16_t* Bt; int M, N, K, lda; };

struct StaticOrder {
    int nM, nN, nwg, G, c;
    __host__ __device__ void init(int M, int N, int G_, int c_) { nM = M / BM; nN = N / BM; nwg = nM * nN; G = G_; c = c_; }
    __host__ __device__ bool next(int i, Unit& u) const {
        const long L = (long)i * G + c; if (L >= nwg) return false;
        int wgid = (int)L; { const int q = nwg / NXCD, r = nwg % NXCD, xcd = wgid % NXCD, off = wgid / NXCD; wgid = (xcd < r ? xcd * (q + 1) : r * (q + 1) + (xcd - r) * q) + off; }
        const int nig = WGM * nN, gid = wgid / nig, fm = gid * WGM, gsz = (nM - fm) < WGM ? (nM - fm) : WGM;
        u.pm = fm + ((wgid % nig) % gsz); u.pn = (wgid % nig) / gsz; return true;
    }
    __device__ __forceinline__ void a_ready(const Unit&) const {}
    __device__ __forceinline__ void done(const Unit&) const {}
};


typedef float f32x2 __attribute__((ext_vector_type(2)));
typedef __bf16 bf16x2_t __attribute__((ext_vector_type(2)));
typedef unsigned u32x2 __attribute__((ext_vector_type(2)));
__device__ __forceinline__ unsigned cvt_pk_bf16(float lo, float hi) { f32x2 v = {lo, hi}; bf16x2_t b = __builtin_convertvector(v, bf16x2_t); return __builtin_bit_cast(unsigned, b); }
constexpr float RMS_EPS = 1e-6f;
typedef unsigned ssq_t;
constexpr float SSQ_SCALE = 4096.f, SSQ_INV = 1.f / 4096.f;
__device__ __forceinline__ void ssq_add(ssq_t* p, float q) { atomicAdd(p, (ssq_t)(q * SSQ_SCALE + 0.5f)); }
__device__ __forceinline__ float ssq_rs(const ssq_t* p, float inv_k) { return __builtin_amdgcn_rsqf((float)(*p) * (inv_k * SSQ_INV) + RMS_EPS); }

struct EpiStore {
    static constexpr bool PERM = true, AFTER_DRAIN = false;
    bf16_t* O; int ldc; const ssq_t* ss; float inv_k; ssq_t* sq0; ssq_t* sq1;
    __device__ __forceinline__ void operator()(const f32x4 (&acc)[2][2][4][2], const Unit& u, int wr, int wc, int fr, int fq) const {
        const int row0 = u.pm * BM + wr * 64 + fr, col0 = u.pn * BM + wc * 32 + 8 * fq;
        ssq_t* sq = sq0 ? (u.pn < 2 ? sq0 : (u.pn == 2 ? sq1 : nullptr)) : nullptr;
#pragma unroll
        for (int ai = 0; ai < 2; ++ai)
#pragma unroll
            for (int m = 0; m < 4; ++m) {
                const int row = row0 + ai * HALF + m * 16;
                const float rs = ss ? ssq_rs(ss + row, inv_k) : 1.f;
                float q = 0.f;
#pragma unroll
                for (int bj = 0; bj < 2; ++bj) {
                    const f32x4 v0 = acc[ai][bj][m][0] * rs, v1 = acc[ai][bj][m][1] * rs;
                    q += (v0[0] * v0[0] + v0[1] * v0[1]) + (v0[2] * v0[2] + v0[3] * v0[3]) + (v1[0] * v1[0] + v1[1] * v1[1]) + (v1[2] * v1[2] + v1[3] * v1[3]);
                    u32x4 w; w.x = cvt_pk_bf16(v0[0], v0[1]); w.y = cvt_pk_bf16(v0[2], v0[3]); w.z = cvt_pk_bf16(v1[0], v1[1]); w.w = cvt_pk_bf16(v1[2], v1[3]);
                    *(u32x4*)(O + (size_t)row * ldc + col0 + bj * HALF) = w;
                }
                if (sq) { q += __shfl_xor(q, 16); q += __shfl_xor(q, 32); if (fq == 0) ssq_add(sq + row, q); }
            }
    }
};
struct EpiLora {
    static constexpr bool PERM = true, AFTER_DRAIN = false;
    bf16_t* O; int ldc; const float* w0; const float* a0;
    __device__ __forceinline__ void operator()(const f32x4 (&acc)[2][2][4][2], const Unit& u, int wr, int wc, int fr, int fq) const {
        const int row0 = u.pm * BM + wr * 64 + fr, col0 = u.pn * BM + wc * 32 + 8 * fq;
        const int kind = u.pn >> 2;
#pragma unroll
        for (int bj = 0; bj < 2; ++bj) {
            const int c = col0 + bj * HALF;
            float bias[8];
#pragma unroll
            for (int j = 0; j < 8; ++j) bias[j] = kind == 0 ? w0[c + j] : (kind == 1 ? a0[c - 1024 + j] : 0.f);
#pragma unroll
            for (int ai = 0; ai < 2; ++ai)
#pragma unroll
                for (int m = 0; m < 4; ++m) {
                    const int row = row0 + ai * HALF + m * 16;
                    float v[8];
#pragma unroll
                    for (int j = 0; j < 8; ++j) {
                        const float t = acc[ai][bj][m][j >> 2][j & 3] + bias[j];
                        const float sg = __builtin_amdgcn_rcpf(1.f + __builtin_amdgcn_exp2f(-1.4426950408889634f * t));
                        v[j] = kind == 0 ? -0.6065306597126334f * sg : (kind == 1 ? sg : t);
                    }
                    u32x4 w; w.x = cvt_pk_bf16(v[0], v[1]); w.y = cvt_pk_bf16(v[2], v[3]); w.z = cvt_pk_bf16(v[4], v[5]); w.w = cvt_pk_bf16(v[6], v[7]);
                    *(u32x4*)(O + (size_t)row * ldc + c) = w;
                }
        }
    }
};
struct EpiSwiGLU {
    static constexpr bool PERM = true, AFTER_DRAIN = false;
    bf16_t* O; int ldc; const ssq_t* ss; float inv_k;
    __device__ __forceinline__ void operator()(const f32x4 (&acc)[2][2][4][2], const Unit& u, int wr, int wc, int fr, int fq) const {
        const int row0 = u.pm * BM + wr * 64 + fr, col0 = u.pn * HALF + wc * 32 + 8 * fq;
#pragma unroll
        for (int ai = 0; ai < 2; ++ai)
#pragma unroll
            for (int m = 0; m < 4; ++m) {
                const int row = row0 + ai * HALF + m * 16;
                const float rs = ssq_rs(ss + row, inv_k);
                float hv[8];
#pragma unroll
                for (int j = 0; j < 8; ++j) {
                    const float gt = acc[ai][0][m][j >> 2][j & 3] * rs, up = acc[ai][1][m][j >> 2][j & 3] * rs;
                    hv[j] = gt * __builtin_amdgcn_rcpf(1.f + __builtin_amdgcn_exp2f(-1.4426950408889634f * gt)) * up;
                }
                u32x4 w; w.x = cvt_pk_bf16(hv[0], hv[1]); w.y = cvt_pk_bf16(hv[2], hv[3]); w.z = cvt_pk_bf16(hv[4], hv[5]); w.w = cvt_pk_bf16(hv[6], hv[7]);
                *(u32x4*)(O + (size_t)row * ldc + col0) = w;
            }
    }
};
struct EpiResid {
    static constexpr bool PERM = false, AFTER_DRAIN = false;
    const float* base; float* out; bf16_t* xb; ssq_t* sq; int ldc; float scale;
    __device__ __forceinline__ void operator()(const f32x4 (&acc)[2][2][4][2], const Unit& u, int wr, int wc, int fr, int fq) const {
        const int row0 = u.pm * BM + wr * 64 + fr, col0 = u.pn * BM + wc * 32 + 4 * fq;
        f32x4 bv[4][4];
#define ER_LOAD(gi) do { const size_t off_ = (size_t)(row0 + ((gi) >> 2) * HALF + ((gi) & 3) * 16) * ldc + col0; \
        _Pragma("unroll") for (int q_ = 0; q_ < 4; ++q_) bv[(gi) & 3][q_] = *(const f32x4*)(base + off_ + (q_ >> 1) * HALF + (q_ & 1) * 16); } while (0)
        ER_LOAD(0); ER_LOAD(1); ER_LOAD(2);
#pragma unroll
        for (int gi = 0; gi < 8; ++gi) {
            if (gi + 3 < 8) ER_LOAD(gi + 3);
            const int ai = gi >> 2, m = gi & 3;
            const size_t off = (size_t)(row0 + ai * HALF + m * 16) * ldc + col0;
            float q = 0.f;
#pragma unroll
            for (int qq = 0; qq < 4; ++qq) {
                const int bj = qq >> 1, n = qq & 1;
                const size_t o2 = off + bj * HALF + n * 16;
                const f32x4 o = bv[gi & 3][qq] + acc[ai][bj][m][n] * scale;
                *(f32x4*)(out + o2) = o;
                if (xb) { u32x2 w; w.x = cvt_pk_bf16(o[0], o[1]); w.y = cvt_pk_bf16(o[2], o[3]); *(u32x2*)(xb + o2) = w; }
                q += (o[0] * o[0] + o[1] * o[1]) + (o[2] * o[2] + o[3] * o[3]);
            }
            if (xb) { q += __shfl_xor(q, 16); q += __shfl_xor(q, 32); if (fq == 0) ssq_add(sq + row0 + ai * HALF + m * 16, q); }
        }
#undef ER_LOAD
    }
};

struct EpiAny {
    static constexpr bool AFTER_DRAIN = false;
    int kind; bool perm; bf16_t* O; int ldc; const void* ss; float inv_k; void* p0; void* p1;
    __device__ __forceinline__ void operator()(const f32x4 (&acc)[2][2][4][2], const Unit& u, int wr, int wc, int fr, int fq) const {
        if (kind == 1) { EpiStore e{O, ldc, (const ssq_t*)ss, inv_k, (ssq_t*)p0, (ssq_t*)p1}; e(acc, u, wr, wc, fr, fq); }
        else if (kind == 2) { EpiSwiGLU e{O, ldc, (const ssq_t*)ss, inv_k}; e(acc, u, wr, wc, fr, fq); }
        else if (kind == 3) { EpiResid e{(const float*)ss, (float*)p0, O, (ssq_t*)p1, ldc, inv_k}; e(acc, u, wr, wc, fr, fq); }
        else { EpiLora e{O, ldc, (const float*)p0, (const float*)p1}; e(acc, u, wr, wc, fr, fq); }
    }
};
template <class Epi, class Sched, bool ALIGN_EPI = false, bool SP2 = false>
__device__ __forceinline__ void gemm_phase(PG8_LAS unsigned char* lds, const Gemm g, const Sched& S, const Epi& E, const int tid_in) {
    const int tid = tid_in, wid = __builtin_amdgcn_readfirstlane(tid >> 6), lane = tid & 63, wr = wid >> 2, wc = wid & 3, fr = lane & 15, fq = lane >> 4;
    const int K = g.K, nt = K / BK;
    unsigned voffA[2], voffB[2];
#pragma unroll
    for (int i = 0; i < 2; ++i) { int R, C; stage_rc(tid * 16 + i * 8192, R, C); const int Rb = E.perm ? ((R & ~31) + perm32(R & 31)) : R;
        voffA[i] = (unsigned)(R * g.lda + C) * 2u; voffB[i] = (unsigned)(Rb * K + C) * 2u; }
    const size_t kstep = (size_t)(BK * 2);
    const size_t hstep = (size_t)HALF * K * 2;
    const size_t tstep = 2 * hstep; const size_t hstepA = (size_t)HALF * g.lda * 2, tstepA = 2 * hstepA;
    const unsigned ldsw = (unsigned)wid * 1024u;
    const int aoff = lds_byte(wr * 64 + fr, fq * 8), boff = lds_byte(wc * 32 + fr, fq * 8);
#define PG8_SA(b, h) (((b) * 2 + (h)) * HTB)
#define PG8_SB(b, h) ((4 + (b) * 2 + (h)) * HTB)
#define PG8_STAGE(bufoff, gbase, voff) do { _Pragma("unroll") for (int _i = 0; _i < 2; ++_i) \
        __builtin_amdgcn_global_load_lds((const unsigned*)((const char*)(gbase) + (voff)[_i]), (PG8_LAS unsigned*)(lds + (bufoff) + ldsw + _i * 8192), 16, 0, 0); } while (0)
#define PG8_LDA(dst, b, h) do { _Pragma("unroll") for (int m = 0; m < 4; ++m) _Pragma("unroll") for (int k = 0; k < 2; ++k) dst[m][k] = *(const PG8_LAS bf16x8*)(lds + PG8_SA(b, h) + aoff + m * 2048 + k * 1024); } while (0)
#define PG8_LDB(dst, b, h) do { _Pragma("unroll") for (int n = 0; n < 2; ++n) _Pragma("unroll") for (int k = 0; k < 2; ++k) dst[n][k] = *(const PG8_LAS bf16x8*)(lds + PG8_SB(b, h) + boff + n * 2048 + k * 1024); } while (0)
#define PG8_MMA(ai, bj, At, Bt) do { __builtin_amdgcn_s_setprio(1); _Pragma("unroll") for (int m = 0; m < 4; ++m) _Pragma("unroll") for (int n = 0; n < 2; ++n) _Pragma("unroll") for (int k = 0; k < 2; ++k) \
        acc[ai][bj][m][n] = __builtin_amdgcn_mfma_f32_16x16x32_bf16(Bt[n][k], At[m][k], acc[ai][bj][m][n], 0, 0, 0); __builtin_amdgcn_s_setprio(0); } while (0)
#define PG8_WAIT_V(n) asm volatile("s_waitcnt vmcnt(" #n ")" ::: "memory")
#define PG8_WAIT_L(n) asm volatile("s_waitcnt lgkmcnt(" #n ")" ::: "memory")
#define PG8_BAR __builtin_amdgcn_s_barrier()
#define PG8_SCHED __builtin_amdgcn_sched_barrier(0)
    Unit cur, nxt; int ui = 0;
    if (!S.next(0, cur)) return;
    f32x4 acc[2][2][4][2];
#pragma unroll
    for (int a = 0; a < 2; ++a)
#pragma unroll
        for (int b = 0; b < 2; ++b)
#pragma unroll
            for (int m = 0; m < 4; ++m)
#pragma unroll
                for (int n = 0; n < 2; ++n) acc[a][b][m][n] = (f32x4){0.f, 0.f, 0.f, 0.f};
    bf16x8 At[4][2], B0[2][2], B1[2][2];
    const char* cA = (const char*)g.A + (size_t)cur.pm * tstepA; const char* cB = (const char*)g.Bt + (size_t)cur.pn * tstep;
    S.a_ready(cur);
    if constexpr (SP2) {
        PG8_STAGE(PG8_SB(0, 0), cB, voffB); PG8_STAGE(PG8_SB(0, 1), cB + hstep, voffB); PG8_STAGE(PG8_SA(0, 0), cA, voffA); PG8_STAGE(PG8_SA(0, 1), cA + hstepA, voffA);
        if (wr == 1) PG8_BAR;
        PG8_WAIT_V(2); PG8_BAR;
        PG8_STAGE(PG8_SB(1, 0), cB + kstep, voffB); PG8_STAGE(PG8_SA(1, 0), cA + kstep, voffA); PG8_STAGE(PG8_SB(1, 1), cB + hstep + kstep, voffB);
        PG8_WAIT_V(6); PG8_BAR;
    } else {
        PG8_STAGE(PG8_SB(0, 0), cB, voffB); PG8_STAGE(PG8_SA(0, 0), cA, voffA); PG8_STAGE(PG8_SB(0, 1), cB + hstep, voffB); PG8_STAGE(PG8_SA(0, 1), cA + hstepA, voffA);
        if (wr == 1) PG8_BAR;
        PG8_WAIT_V(4); PG8_BAR;
        PG8_STAGE(PG8_SB(1, 0), cB + kstep, voffB); PG8_STAGE(PG8_SA(1, 0), cA + kstep, voffA); PG8_STAGE(PG8_SB(1, 1), cB + hstep + kstep, voffB);
        PG8_WAIT_V(6); PG8_BAR;
    }
    for (;;) {
        const bool has_next = S.next(ui + 1, nxt);
        const char* nA = has_next ? (const char*)g.A + (size_t)nxt.pm * tstepA : cA; const char* nB = has_next ? (const char*)g.Bt + (size_t)nxt.pn * tstep : cB;
        for (int t = 0; t < nt; t += 2) {
            const bool last = (t == nt - 2);
            const char* a1 = cA + (size_t)(t + 1) * kstep;
            const char* a2 = last ? nA : cA + (size_t)(t + 2) * kstep; const char* b2 = last ? nB : cB + (size_t)(t + 2) * kstep;
            const char* a3 = a2 + kstep; const char* b3 = b2 + kstep;
            if (last && has_next) S.a_ready(nxt);
            if constexpr (SP2) {
            PG8_LDB(B0, 0, 0); PG8_LDB(B1, 0, 1); PG8_SCHED; PG8_LDA(At, 0, 0); PG8_STAGE(PG8_SA(1, 1), a1 + hstepA, voffA);
            PG8_WAIT_V(8); PG8_WAIT_L(0); PG8_BAR; PG8_MMA(0, 0, At, B0); PG8_MMA(0, 1, At, B1); PG8_BAR; PG8_SCHED;
            PG8_LDA(At, 0, 1); PG8_STAGE(PG8_SB(0, 0), b2, voffB); PG8_STAGE(PG8_SB(0, 1), b2 + hstep, voffB); PG8_STAGE(PG8_SA(0, 0), a2, voffA);
            PG8_WAIT_V(8); PG8_WAIT_L(0); PG8_BAR; PG8_MMA(1, 0, At, B0); PG8_MMA(1, 1, At, B1); PG8_BAR; PG8_SCHED;
            PG8_LDB(B0, 1, 0); PG8_LDB(B1, 1, 1); PG8_SCHED; PG8_LDA(At, 1, 0); PG8_STAGE(PG8_SA(0, 1), a2 + hstepA, voffA);
            PG8_WAIT_V(8); PG8_WAIT_L(0); PG8_BAR; PG8_MMA(0, 0, At, B0); PG8_MMA(0, 1, At, B1); PG8_BAR; PG8_SCHED;
            PG8_LDA(At, 1, 1); PG8_STAGE(PG8_SB(1, 0), b3, voffB); PG8_STAGE(PG8_SB(1, 1), b3 + hstep, voffB); PG8_STAGE(PG8_SA(1, 0), a3, voffA);
            PG8_WAIT_V(8); PG8_WAIT_L(0); PG8_BAR; PG8_MMA(1, 0, At, B0); PG8_MMA(1, 1, At, B1); PG8_BAR; PG8_SCHED;
            } else {
            PG8_LDB(B0, 0, 0); PG8_SCHED; PG8_LDA(At, 0, 0); PG8_STAGE(PG8_SA(1, 1), a1 + hstepA, voffA);
            PG8_WAIT_L(8); PG8_BAR; PG8_WAIT_L(0); PG8_MMA(0, 0, At, B0); PG8_BAR; PG8_SCHED;
            PG8_LDB(B1, 0, 1); PG8_STAGE(PG8_SB(0, 0), b2, voffB);
            PG8_BAR; PG8_WAIT_L(0); PG8_MMA(0, 1, At, B1); PG8_BAR;
            PG8_LDA(At, 0, 1); PG8_STAGE(PG8_SA(0, 0), a2, voffA);
            PG8_BAR; PG8_WAIT_L(0); PG8_MMA(1, 0, At, B0); PG8_BAR; PG8_SCHED;
            PG8_STAGE(PG8_SB(0, 1), b2 + hstep, voffB);
            PG8_WAIT_V(6); PG8_BAR; PG8_MMA(1, 1, At, B1); PG8_BAR;
            PG8_LDB(B0, 1, 0); PG8_SCHED; PG8_LDA(At, 1, 0); PG8_STAGE(PG8_SA(0, 1), a2 + hstepA, voffA);
            PG8_WAIT_L(8); PG8_BAR; PG8_WAIT_L(0); PG8_MMA(0, 0, At, B0); PG8_BAR; PG8_SCHED;
            PG8_LDB(B1, 1, 1); PG8_STAGE(PG8_SB(1, 0), b3, voffB);
            PG8_BAR; PG8_WAIT_L(0); PG8_MMA(0, 1, At, B1); PG8_BAR;
            PG8_LDA(At, 1, 1); PG8_STAGE(PG8_SA(1, 0), a3, voffA);
            PG8_BAR; PG8_WAIT_L(0); PG8_MMA(1, 0, At, B0); PG8_BAR; PG8_SCHED;
            PG8_STAGE(PG8_SB(1, 1), b3 + hstep, voffB);
            PG8_WAIT_V(6); PG8_BAR; PG8_MMA(1, 1, At, B1); PG8_BAR;
            }
        }
        if constexpr (ALIGN_EPI) { if (wr == 0) PG8_BAR; }
        if constexpr (!Epi::AFTER_DRAIN) { E(acc, cur, wr, wc, fr, fq); S.done(cur); }
        if (!has_next) break;
#pragma unroll
        for (int a = 0; a < 2; ++a)
#pragma unroll
            for (int b = 0; b < 2; ++b)
#pragma unroll
                for (int m = 0; m < 4; ++m)
#pragma unroll
                    for (int n = 0; n < 2; ++n) acc[a][b][m][n] = (f32x4){0.f, 0.f, 0.f, 0.f};
        cur = nxt; cA = nA; cB = nB; ++ui;
        if constexpr (ALIGN_EPI) { if (wr == 1) PG8_BAR; }
    }
    PG8_WAIT_V(0);
    if constexpr (!ALIGN_EPI) { if (wr == 0) PG8_BAR; }
    PG8_BAR;
    if constexpr (Epi::AFTER_DRAIN) { E.fused(acc, cur, wr, wc, fr, fq, lds, wid, lane); S.done(cur); }
#undef PG8_SA
#undef PG8_SB
#undef PG8_STAGE
#undef PG8_LDA
#undef PG8_LDB
#undef PG8_MMA
#undef PG8_WAIT_V
#undef PG8_WAIT_L
#undef PG8_BAR
#undef PG8_SCHED
}
}

#define LAS __attribute__((address_space(3)))
using pg8::bf16_t; using pg8::bf16x8; using pg8::f32x4; using pg8::u32x4; using pg8::u32x2; using pg8::f32x2; using pg8::cvt_pk_bf16; using pg8::ssq_t;
typedef float f32x16 __attribute__((ext_vector_type(16)));
typedef short s16x4 __attribute__((ext_vector_type(4)));
typedef short v4i16_t __attribute__((ext_vector_type(4)));

constexpr int NB = 8, SEQ = 2048, DM = 2048, MT = NB * SEQ, FF = 5632, MEML = 256;
constexpr int ABN = 4896, ABP = 5120, CDN = 3872, CDP = 4096;
constexpr float EPS = 1e-6f, LOG2E = 1.4426950408889634f;
constexpr float LAMBDA_INIT = 0.3555090675f;
constexpr int NPHASE = 26;
constexpr int NTHREADS = 512;
constexpr int LDS_BYTES = 147456;

constexpr size_t MiB = (size_t)1 << 20;
constexpr size_t WS_SS = 656 * MiB, WS_CS64 = 1 * MiB, WS_CS32 = 5 * MiB, WS_MEMB = 7 * MiB, WS_MEMKV = 15 * MiB, WS_MEMVT = 19 * MiB;
constexpr size_t WS_WGUA = 21 * MiB, WS_WDA = 65 * MiB, WS_WGUB = 87 * MiB, WS_WDB = 131 * MiB;
constexpr size_t WS_WABIN = 153 * MiB, WS_WABOUT = 173 * MiB, WS_WCDIN = 181 * MiB, WS_WCDOUT = 197 * MiB, WS_WUQ = 205 * MiB, WS_WUKV = 207 * MiB;
constexpr size_t WS_WMQ = 208 * MiB, WS_WMO = 212 * MiB, WS_WMKV = 216 * MiB, WS_WLORA = 220 * MiB;
constexpr size_t WS_XB = 224 * MiB, WS_BIG = 288 * MiB, WS_BAR = 658 * MiB, WS_WGUC = 659 * MiB, WS_WDC = 703 * MiB, WS_END = 725 * MiB;
constexpr size_t B_H = 0;
constexpr size_t B0_U = 0, B0_LIN = 160 * MiB, B0_LOUT = 176 * MiB, B0_VT = 272 * MiB, B0_Y = 280 * MiB;
constexpr size_t B1_U = 0, B1_Q = 128 * MiB, B1_KV = 176 * MiB, B1_VTM = 240 * MiB, B1_VTD = 272 * MiB, B1_Y = 304 * MiB;
constexpr size_t BM_Q = 0, BM_O = 16 * MiB;
enum { SS_A0 = 0, SS_B0, SS_C0, SS_D0, SS_A1, SS_B1, SS_C1, SS_D1, SS_CQ, SS_CKV, SS_MEM, SS_DUMMY, SS_N };

enum { I_X = 0, I_MEM, I_POS, I_F1N, I_F1G, I_F1U, I_F1D, I_MIXN, I_ABIN, I_ABOUT, I_SWAQN, I_SWAKN, I_SINKS, I_MU, I_W0, I_W2, I_A0, I_A2, I_G2, I_KK, I_KA, I_RK, I_GNG, I_GNB,
       I_CDIN, I_CDOUT, I_CQN, I_CKVN, I_WUQ, I_WUKV, I_QNOPEN, I_KNOPEN, I_QROPEN, I_KROPEN, I_DQN, I_DKN, I_LQ1, I_LK1, I_LQ2, I_LK2, I_SUBLN, I_MXN, I_MXWQ, I_MXQN, I_MXWO,
       I_MEMN, I_MEMWKV, I_MEMKN, I_F2N, I_F2G, I_F2U, I_F2D, N_IN };

struct Params { const float* in[N_IN]; float* out; unsigned char* ws; int ph_lo, ph_hi; };

__device__ __forceinline__ float bf2f(bf16_t v) { return __uint_as_float((unsigned)v << 16); }
__device__ __forceinline__ bf16_t f2bf(float f) { return (bf16_t)(cvt_pk_bf16(f, 0.f) & 0xffffu); }
__device__ __forceinline__ float wave_sum(float v) {
#pragma unroll
    for (int o = 1; o < 64; o <<= 1) v += __shfl_xor(v, o);
    return v;
}
__device__ __forceinline__ float fexp2(float x) { return __builtin_amdgcn_exp2f(x); }

__device__ __forceinline__ void conv_matrix(const float* W, int K, int N, const float* gain, bf16_t* WT, int Kd, int mode, int row_off, LAS float* scr, int lane, int gw, int NGW) {
    const int nblk = N / 32, items = nblk * (K / 64);
    for (int it = gw; it < items; it += NGW) {
        const int kb = it / nblk, nb = it % nblk, k0 = 64 * kb, n0 = 32 * nb;
        float wv[32];
#pragma unroll
        for (int i = 0; i < 32; ++i) wv[i] = W[(size_t)(k0 + 2 * i + (lane >> 5)) * N + n0 + (lane & 31)];
        if (gain) {
#pragma unroll
            for (int i = 0; i < 32; ++i) wv[i] *= gain[k0 + 2 * i + (lane >> 5)];
        }
#pragma unroll
        for (int i = 0; i < 32; ++i) scr[(2 * i + (lane >> 5)) * 33 + (lane & 31)] = wv[i];
        asm volatile("s_waitcnt lgkmcnt(0)" ::: "memory");
        const int c = lane & 7;
        const int rbase = mode == 0 ? row_off + n0 : ((n0 >> 7) * 256 + (n0 & 127) + (mode == 2 ? 128 : 0));
#pragma unroll
        for (int j = 0; j < 4; ++j) { const int n = (lane >> 3) + 8 * j; const LAS float* s = scr + (8 * c) * 33 + n;
            u32x4 o; o.x = cvt_pk_bf16(s[0 * 33], s[1 * 33]); o.y = cvt_pk_bf16(s[2 * 33], s[3 * 33]); o.z = cvt_pk_bf16(s[4 * 33], s[5 * 33]); o.w = cvt_pk_bf16(s[6 * 33], s[7 * 33]);
            *(u32x4*)(WT + (size_t)(rbase + n) * Kd + k0 + 8 * c) = o; }
        asm volatile("s_waitcnt lgkmcnt(0)" ::: "memory");
    }
}
__device__ __forceinline__ void conv_ffn(const LAS Params* PL, int L, int which  , LAS float* scr, int lane, int gw, int NGW) {
    const float* nrm = PL->in[which ? I_F2N : I_F1N] + (size_t)L * DM;
    const float* wg = PL->in[which ? I_F2G : I_F1G] + (size_t)L * DM * FF;
    const float* wu = PL->in[which ? I_F2U : I_F1U] + (size_t)L * DM * FF;
    const float* wd = PL->in[which ? I_F2D : I_F1D] + (size_t)L * FF * DM;
    bf16_t* gu = (bf16_t*)(PL->ws + (which ? (L ? WS_WGUC : WS_WGUB) : WS_WGUA)); bf16_t* dn = (bf16_t*)(PL->ws + (which ? (L ? WS_WDC : WS_WDB) : WS_WDA));
    conv_matrix(wg, DM, FF, nrm, gu, DM, 1, 0, scr, lane, gw, NGW);
    conv_matrix(wu, DM, FF, nrm, gu, DM, 2, 0, scr, lane, gw, NGW);
    conv_matrix(wd, FF, DM, nullptr, dn, FF, 0, 0, scr, lane, gw, NGW);
}
__device__ __forceinline__ void row_to_bf16(const float* xrow, bf16_t* orow, ssq_t* ssq, int lane) {
    const f32x4* xr = (const f32x4*)xrow + lane; float s = 0.f; f32x4 v[8];
#pragma unroll
    for (int j = 0; j < 8; ++j) { v[j] = xr[64 * j]; s += (v[j][0] * v[j][0] + v[j][1] * v[j][1]) + (v[j][2] * v[j][2] + v[j][3] * v[j][3]); }
    s = wave_sum(s);
    u32x2* o8 = (u32x2*)orow + lane;
#pragma unroll
    for (int j = 0; j < 8; ++j) { u32x2 w; w.x = cvt_pk_bf16(v[j][0], v[j][1]); w.y = cvt_pk_bf16(v[j][2], v[j][3]); o8[64 * j] = w; }
    if (lane == 0) *ssq = (ssq_t)(s * pg8::SSQ_SCALE + 0.5f);
}
__device__ __forceinline__ void vt_transpose(const bf16_t* src, int pitch, int col0, int hstride, int nh, int DVh, int Sk, bf16_t* dst, int lane, int gw, int NGW) {
    const int sblk = Sk / 64, items = NB * nh * sblk;
    for (int it = gw; it < items; it += NGW) {
        const int sb = it % sblk, hd = (it / sblk) % nh, b = it / (sblk * nh);
        const int s = sb * 64 + lane;
        const bf16_t* sp = src + (size_t)(b * Sk + s) * pitch + col0 + hd * hstride;
        bf16_t* dp = dst + (size_t)((b * nh + hd) * DVh) * Sk + s;
        for (int dc = 0; dc < DVh / 8; ++dc) {
            const bf16x8 v = *(const bf16x8*)(sp + dc * 8);
#pragma unroll
            for (int j = 0; j < 8; ++j) dp[(size_t)(dc * 8 + j) * Sk] = (bf16_t)v[j];
        }
    }
}
template <int N>
__device__ __forceinline__ void norm_rope_row(bf16_t* p, int hstride, int nheads, const float* g, const f32x2* cs, int lane) {
    constexpr int GL = N / 8, HPP = 64 / GL, HALFN = N / 2;
    const int j = lane % GL, hl = lane / GL;
    const f32x4 g0 = *(const f32x4*)(g + 4 * j), g1 = *(const f32x4*)(g + HALFN + 4 * j);
    f32x4 c01 = {1.f, 0.f, 1.f, 0.f}, c23 = {1.f, 0.f, 1.f, 0.f};
    if (cs) { c01 = *(const f32x4*)(cs + 4 * j); c23 = *(const f32x4*)(cs + 4 * j + 2); }
    for (int h0 = 0; h0 < nheads; h0 += HPP) {
        const int hd = h0 + hl; const bool act = hd < nheads;
        bf16_t* q = p + (size_t)hd * hstride + 4 * j;
        u32x2 w0 = {0u, 0u}, w1 = {0u, 0u};
        if (act) { w0 = *(const u32x2*)q; w1 = *(const u32x2*)(q + HALFN); }
        float x0[4] = {__uint_as_float(w0.x << 16), __uint_as_float(w0.x & 0xffff0000u), __uint_as_float(w0.y << 16), __uint_as_float(w0.y & 0xffff0000u)};
        float x1[4] = {__uint_as_float(w1.x << 16), __uint_as_float(w1.x & 0xffff0000u), __uint_as_float(w1.y << 16), __uint_as_float(w1.y & 0xffff0000u)};
        float ss = (x0[0] * x0[0] + x0[1] * x0[1]) + (x0[2] * x0[2] + x0[3] * x0[3]) + (x1[0] * x1[0] + x1[1] * x1[1]) + (x1[2] * x1[2] + x1[3] * x1[3]);
#pragma unroll
        for (int o = 1; o < GL; o <<= 1) ss += __shfl_xor(ss, o);
        const float rs = __builtin_amdgcn_rsqf(ss * (1.f / N) + EPS);
        float y0[4], y1[4];
#pragma unroll
        for (int e = 0; e < 4; ++e) {
            const float a = x0[e] * rs * g0[e], b = x1[e] * rs * g1[e];
            const float co = e < 2 ? c01[2 * e] : c23[2 * (e - 2)], si = e < 2 ? c01[2 * e + 1] : c23[2 * (e - 2) + 1];
            y0[e] = a * co - b * si; y1[e] = a * si + b * co;
        }
        if (act) { u32x2 o0, o1; o0.x = cvt_pk_bf16(y0[0], y0[1]); o0.y = cvt_pk_bf16(y0[2], y0[3]); o1.x = cvt_pk_bf16(y1[0], y1[1]); o1.y = cvt_pk_bf16(y1[2], y1[3]);
            *(u32x2*)q = o0; *(u32x2*)(q + HALFN) = o1; }
    }
}

struct AttSrc { const bf16_t* q; int qp; const bf16_t* ka; int kap; const bf16_t* kb; int kbp; const bf16_t* v; int vp; int SK; const f32x2* qcs; const float* qg2; };
__device__ __forceinline__ int crow(int r, int hi) { return (r & 3) + 8 * (r >> 2) + 4 * hi; }
#define MFMA32(a, b, c) __builtin_amdgcn_mfma_f32_32x32x16_bf16((a), (b), (c), 0, 0, 0)

template <int DK, int DV, int MODE>
__device__ __forceinline__ void attn_tile(const LAS unsigned char* Kl, const LAS unsigned char* Vl, const bf16x8 (&qf)[DK / 16], f32x16 (&o)[DV / 32], float& m, float& l,
                                          int t, int q0, int wid, int r, int h, int qrow, float c) {
    constexpr int KS = DK / 16, KSTR = DK * 2 + 16, VSTR = DV * 2 + 16;
        const int k0 = t * 64;
        if (MODE != 2) { const int qlo = q0 + wid * 32; if (k0 > qlo + 31 || (MODE == 1 && qlo - (k0 + 63) >= 128)) return; }
        f32x16 p0, p1;
#pragma unroll
        for (int i = 0; i < 16; ++i) { p0[i] = 0.f; p1[i] = 0.f; }
#pragma unroll
        for (int ks = 0; ks < KS; ++ks) {
            const bf16x8 a0 = *(const LAS bf16x8*)(Kl + r * KSTR + (16 * ks + 8 * h) * 2);
            const bf16x8 a1 = *(const LAS bf16x8*)(Kl + (r + 32) * KSTR + (16 * ks + 8 * h) * 2);
            p0 = MFMA32(a0, qf[ks], p0); p1 = MFMA32(a1, qf[ks], p1);
        }
        bool need_mask = false;
        if (MODE == 0) need_mask = (k0 + 63 > q0 + wid * 32);
        if (MODE == 1) need_mask = (k0 + 63 > q0 + wid * 32) || (q0 + wid * 32 + 31 - k0 >= 128);
        float mx = -INFINITY;
#pragma unroll
        for (int i = 0; i < 16; ++i) {
            float s0 = p0[i] * c, s1 = p1[i] * c;
            if (need_mask) {
                const int key0 = k0 + crow(i, h), key1 = key0 + 32;
                const bool v0 = (key0 <= qrow) && (MODE != 1 || qrow - key0 < 128);
                const bool v1 = (key1 <= qrow) && (MODE != 1 || qrow - key1 < 128);
                s0 = v0 ? s0 : -INFINITY; s1 = v1 ? s1 : -INFINITY;
            }
            p0[i] = s0; p1[i] = s1; mx = fmaxf(mx, fmaxf(s0, s1));
        }
        { const auto rr_ = __builtin_amdgcn_permlane32_swap(__float_as_uint(mx), __float_as_uint(mx), false, false);
          mx = fmaxf(__uint_as_float(rr_[0]), __uint_as_float(rr_[1])); }
        const float m_new = fmaxf(m, mx), m_use = (m_new == -INFINITY) ? 0.f : m_new;
        const float alpha = fexp2(m - m_use);
        float ls = 0.f;
#pragma unroll
        for (int i = 0; i < 16; ++i) { p0[i] = fexp2(p0[i] - m_use); p1[i] = fexp2(p1[i] - m_use); ls += p0[i] + p1[i]; }
        l = l * alpha + ls; m = m_new;
#pragma unroll
        for (int d = 0; d < DV / 32; ++d)
#pragma unroll
            for (int i = 0; i < 16; ++i) o[d][i] *= alpha;
        bf16x8 pb[4];
#pragma unroll
        for (int sx = 0; sx < 2; ++sx) {
            u32x4 w0, w1;
            w0.x = cvt_pk_bf16(p0[8 * sx + 0], p0[8 * sx + 1]); w0.y = cvt_pk_bf16(p0[8 * sx + 2], p0[8 * sx + 3]); w0.z = cvt_pk_bf16(p0[8 * sx + 4], p0[8 * sx + 5]); w0.w = cvt_pk_bf16(p0[8 * sx + 6], p0[8 * sx + 7]);
            w1.x = cvt_pk_bf16(p1[8 * sx + 0], p1[8 * sx + 1]); w1.y = cvt_pk_bf16(p1[8 * sx + 2], p1[8 * sx + 3]); w1.z = cvt_pk_bf16(p1[8 * sx + 4], p1[8 * sx + 5]); w1.w = cvt_pk_bf16(p1[8 * sx + 6], p1[8 * sx + 7]);
            pb[sx] = __builtin_bit_cast(bf16x8, w0); pb[2 + sx] = __builtin_bit_cast(bf16x8, w1);
        }
#pragma unroll
        for (int d = 0; d < DV / 32; ++d)
#pragma unroll
            for (int t4 = 0; t4 < 4; ++t4) {
                const LAS unsigned char* vp_ = Vl + (16 * t4 + 4 * h + ((r & 15) >> 2)) * VSTR + (32 * d + 16 * (r >> 4) + 4 * (r & 3)) * 2;
                const s16x4 lo = __builtin_bit_cast(s16x4, __builtin_amdgcn_ds_read_tr16_b64_v4i16((LAS v4i16_t*)vp_));
                const s16x4 hi = __builtin_bit_cast(s16x4, __builtin_amdgcn_ds_read_tr16_b64_v4i16((LAS v4i16_t*)(vp_ + 8 * VSTR)));
                const bf16x8 vf = __builtin_shufflevector(lo, hi, 0, 1, 2, 3, 4, 5, 6, 7);
                o[d] = MFMA32(vf, pb[t4], o[d]);
                if (DV > 64 && t4 == 3) __builtin_amdgcn_sched_barrier(0);
            }
}
template <int DKA, int DKB, int DV, int MODE  >
__device__ __forceinline__ void attn_unit(LAS unsigned char* lds, const AttSrc& s, int q0, float c, float sink_l2, const float* qg, f32x16 (&o)[DV / 32], const int tid) {
    constexpr int DK = DKA + DKB, KS = DK / 16, KSTR = DK * 2 + 16, VSTR = DV * 2 + 16, VCH = DV / 8, KBYTES = 64 * KSTR, VBYTES = 64 * VSTR, TB = KBYTES + VBYTES;
    constexpr int KCH = DK / 8, NKC = 64 * KCH, NKR = (NKC + NTHREADS - 1) / NTHREADS, NVR = DV * 8 / NTHREADS;
    const int lane = tid & 63, wid = tid >> 6, r = lane & 31, h = lane >> 5;
    const int qrow = q0 + wid * 32 + r;
    bf16x8 qf[KS];
#pragma unroll
    for (int ks = 0; ks < KS; ++ks) qf[ks] = *(const bf16x8*)(s.q + (size_t)qrow * s.qp + 16 * ks + 8 * h);
    if (MODE == 2) {
        float ssq = 0.f;
#pragma unroll
        for (int ks = 0; ks < KS; ++ks)
#pragma unroll
            for (int j = 0; j < 8; ++j) { const float f = bf2f((bf16_t)qf[ks][j]); ssq += f * f; }
        ssq += __shfl_xor(ssq, 32);
        const float rs = __builtin_amdgcn_rsqf(ssq / (float)DK + EPS);
#pragma unroll
        for (int ks = 0; ks < KS; ++ks)
#pragma unroll
            for (int j = 0; j < 8; ++j) qf[ks][j] = (short)f2bf(bf2f((bf16_t)qf[ks][j]) * rs * qg[16 * ks + 8 * h + j]);
    }
    if (MODE == 1) {
        float xq[4][8]; float ssq = 0.f;
#pragma unroll
        for (int ks = 0; ks < 4; ++ks)
#pragma unroll
            for (int j = 0; j < 8; ++j) { xq[ks][j] = bf2f((bf16_t)qf[ks][j]); ssq += xq[ks][j] * xq[ks][j]; }
        ssq += __shfl_xor(ssq, 32);
        const float rs = __builtin_amdgcn_rsqf(ssq * (1.f / 64.f) + EPS);
#pragma unroll
        for (int ks = 0; ks < 2; ++ks)
#pragma unroll
            for (int j = 0; j < 8; ++j) { const int cidx = 16 * ks + 8 * h + j;
                const float a = xq[ks][j] * rs * qg[cidx], bq = xq[ks + 2][j] * rs * qg[cidx + 32];
                const f32x2 t = s.qcs[(size_t)qrow * 32 + cidx];
                qf[ks][j] = (short)f2bf(a * t.x - bq * t.y); qf[ks + 2][j] = (short)f2bf(a * t.y + bq * t.x); }
    }
    if (MODE == 0 && DKB == 32) {
        float xn[4][8], xp[2][8]; float s1 = 0.f, s2 = 0.f;
#pragma unroll
        for (int ks = 0; ks < 4; ++ks)
#pragma unroll
            for (int j = 0; j < 8; ++j) { xn[ks][j] = bf2f((bf16_t)qf[ks][j]); s1 += xn[ks][j] * xn[ks][j]; }
#pragma unroll
        for (int ks = 0; ks < 2; ++ks)
#pragma unroll
            for (int j = 0; j < 8; ++j) { xp[ks][j] = bf2f((bf16_t)qf[4 + ks][j]); s2 += xp[ks][j] * xp[ks][j]; }
        s1 += __shfl_xor(s1, 32); s2 += __shfl_xor(s2, 32);
        const float r1 = __builtin_amdgcn_rsqf(s1 * (1.f / 64.f) + EPS), r2 = __builtin_amdgcn_rsqf(s2 * (1.f / 32.f) + EPS);
#pragma unroll
        for (int ks = 0; ks < 4; ++ks)
#pragma unroll
            for (int j = 0; j < 8; ++j) qf[ks][j] = (short)f2bf(xn[ks][j] * r1 * qg[16 * ks + 8 * h + j]);
#pragma unroll
        for (int j = 0; j < 8; ++j) { const int cidx = 8 * h + j;
            const float a = xp[0][j] * r2 * s.qg2[cidx], bq = xp[1][j] * r2 * s.qg2[cidx + 16];
            const f32x2 t = s.qcs[(size_t)qrow * 16 + cidx];
            qf[4][j] = (short)f2bf(a * t.x - bq * t.y); qf[5][j] = (short)f2bf(a * t.y + bq * t.x); }
    }
    const int t_lo = MODE == 1 ? (q0 >= 128 ? q0 / 64 - 2 : 0) : 0;
    const int t_hi = MODE == 2 ? s.SK / 64 : q0 / 64 + 4;
    float m = MODE == 1 ? sink_l2 : -INFINITY;
    float l = (MODE == 1 && h == 0) ? 1.f : 0.f;
#pragma unroll
    for (int d = 0; d < DV / 32; ++d)
#pragma unroll
        for (int i = 0; i < 16; ++i) o[d][i] = 0.f;
    constexpr bool PF2 = !(DV == 128 && MODE == 0);
    u32x4 krA[NKR], vrA[NVR], krB[PF2 ? NKR : 1], vrB[PF2 ? NVR : 1];
#define ATT_LOAD(KR, VR, t) do { const int k0_ = (t) * 64; \
        _Pragma("unroll") for (int i = 0; i < NKR; ++i) { const int cc = tid + NTHREADS * i; if (cc < NKC) { const int row = cc / KCH, ch = cc % KCH; \
            const bf16_t* sp = (ch < DKA / 8) ? s.ka + (size_t)(k0_ + row) * s.kap + ch * 8 : s.kb + (size_t)(k0_ + row) * s.kbp + (ch - DKA / 8) * 8; KR[i] = *(const u32x4*)sp; } } \
        _Pragma("unroll") for (int i = 0; i < NVR; ++i) { const int cc = tid + NTHREADS * i; const int key = cc / VCH, ch = cc % VCH; VR[i] = *(const u32x4*)(s.v + (size_t)(k0_ + key) * s.vp + ch * 8); } } while (0)
#define ATT_STORE(KR, VR, Kl, Vl) do { \
        _Pragma("unroll") for (int i = 0; i < NKR; ++i) { const int cc = tid + NTHREADS * i; if (cc < NKC) { const int row = cc / KCH, ch = cc % KCH; *(LAS u32x4*)((Kl) + row * KSTR + ch * 16) = KR[i]; } } \
        _Pragma("unroll") for (int i = 0; i < NVR; ++i) { const int cc = tid + NTHREADS * i; const int key = cc / VCH, ch = cc % VCH; *(LAS u32x4*)((Vl) + key * VSTR + ch * 16) = VR[i]; } } while (0)
    ATT_LOAD(krA, vrA, t_lo);
    if (PF2) { if (t_lo + 1 < t_hi) ATT_LOAD(krB, vrB, t_lo + 1); }
    constexpr int STEP = PF2 ? 2 : 1;
    for (int t = t_lo; t < t_hi; t += STEP) {
        {
            LAS unsigned char* Kl = lds + (PF2 ? 0 : ((t - t_lo) & 1)) * TB; LAS unsigned char* Vl = Kl + KBYTES;
            ATT_STORE(krA, vrA, Kl, Vl);
            __syncthreads();
            if (t + STEP < t_hi) ATT_LOAD(krA, vrA, t + STEP);
            attn_tile<DK, DV, MODE>(Kl, Vl, qf, o, m, l, t, q0, wid, r, h, qrow, c);
        }
        if (PF2) { if (t + 1 < t_hi) {
            LAS unsigned char* Kl = lds + TB; LAS unsigned char* Vl = Kl + KBYTES;
            ATT_STORE(krB, vrB, Kl, Vl);
            __syncthreads();
            if (t + 3 < t_hi) ATT_LOAD(krB, vrB, t + 3);
            attn_tile<DK, DV, MODE>(Kl, Vl, qf, o, m, l, t + 1, q0, wid, r, h, qrow, c);
        } }
    }
#undef ATT_LOAD
#undef ATT_STORE
    { const auto rl_ = __builtin_amdgcn_permlane32_swap(__float_as_uint(l), __float_as_uint(l), false, false); l = __uint_as_float(rl_[0]) + __uint_as_float(rl_[1]); }
    const float inv = 1.f / l;
#pragma unroll
    for (int d = 0; d < DV / 32; ++d)
#pragma unroll
        for (int i = 0; i < 16; ++i) o[d][i] *= inv;
    __syncthreads();
}
template <int DV>
__device__ __forceinline__ void attn_store(const f32x16 (&o)[DV / 32], bf16_t* yrow, int h) {
#pragma unroll
    for (int d = 0; d < DV / 32; ++d)
#pragma unroll
        for (int p = 0; p < 2; ++p) {
            const int ie = 2 * p, io = 2 * p + 1;
            const unsigned x0 = cvt_pk_bf16(o[d][4 * ie], o[d][4 * ie + 1]), x1 = cvt_pk_bf16(o[d][4 * ie + 2], o[d][4 * ie + 3]);
            const unsigned y0 = cvt_pk_bf16(o[d][4 * io], o[d][4 * io + 1]), y1 = cvt_pk_bf16(o[d][4 * io + 2], o[d][4 * io + 3]);
            const auto r0 = __builtin_amdgcn_permlane32_swap(x0, y0, false, false);
            const auto r1 = __builtin_amdgcn_permlane32_swap(x1, y1, false, false);
            u32x4 w; w.x = r0[0]; w.y = r1[0]; w.z = r0[1]; w.w = r1[1];
            *(u32x4*)(yrow + 32 * d + 8 * (2 * p + h)) = w;
        }
}

constexpr int TC = 32;
#define DPP_ADD(v, ctrl) ((v) + __int_as_float(__builtin_amdgcn_update_dpp(0, __float_as_int(v), (ctrl), 0xF, 0xF, true)))
__device__ __forceinline__ float red8(float v) { v = DPP_ADD(v, 0xB1); v = DPP_ADD(v, 0x4E); v = DPP_ADD(v, 0x141); return v; }

__device__ __forceinline__ void rwkv_unit(LAS unsigned char* lds, const LAS Params* PL, int b, int h, const int tid) {
    const bf16_t* u = (const bf16_t*)(PL->ws + WS_BIG + B0_U); const bf16_t* lo = (const bf16_t*)(PL->ws + WS_BIG + B0_LOUT); bf16_t* y = (bf16_t*)(PL->ws + WS_BIG + B0_Y);
    LAS float* A = (LAS float*)lds;
    LAS float* Gb = A + 2 * TC * 384;
    LAS float* Yb = Gb + 2 * TC * 64;
    LAS float* BON = Yb + 2 * TC * 64;
    const int lane = tid & 63, wid = tid >> 6;
    constexpr int NC = SEQ / TC;
    if (wid < 4) {
        const int rg = tid >> 3, jg = tid & 7;
        f32x2 S[8];
#pragma unroll
        for (int j = 0; j < 8; ++j) S[j] = (f32x2){0.f, 0.f};
        __syncthreads();
        for (int chn = 0; chn < NC; ++chn) {
            const LAS float* Ab = A + (chn & 1) * TC * 384 + 8 * jg;
            const LAS float* Av = A + (chn & 1) * TC * 384 + 320 + rg;
            LAS float* Yc = Yb + (chn & 1) * TC * 64 + rg;
#define RW_LV(V, tl) do { const LAS float* a_ = Ab + (tl) * 384; V##d0 = *(const LAS f32x4*)(a_); V##d1 = *(const LAS f32x4*)(a_ + 4); V##n0 = *(const LAS f32x4*)(a_ + 64); V##n1 = *(const LAS f32x4*)(a_ + 68); \
                V##e0 = *(const LAS f32x4*)(a_ + 128); V##e1 = *(const LAS f32x4*)(a_ + 132); V##k0 = *(const LAS f32x4*)(a_ + 192); V##k1 = *(const LAS f32x4*)(a_ + 196); \
                V##r0 = *(const LAS f32x4*)(a_ + 256); V##r1 = *(const LAS f32x4*)(a_ + 260); V##va = Av[(tl) * 384]; V##vb = Av[(tl) * 384 + 32]; } while (0)
#define RW_ROW2(V, yo) do { \
                f32x2 accA = S[0] * (f32x2){V##n0[0], V##n0[1]}, accB = S[4] * (f32x2){V##n0[0], V##n0[1]}; \
                f32x2 acc2A = S[2] * (f32x2){V##n1[0], V##n1[1]}, acc2B = S[6] * (f32x2){V##n1[0], V##n1[1]}; \
                accA = S[1] * (f32x2){V##n0[2], V##n0[3]} + accA; accB = S[5] * (f32x2){V##n0[2], V##n0[3]} + accB; \
                acc2A = S[3] * (f32x2){V##n1[2], V##n1[3]} + acc2A; acc2B = S[7] * (f32x2){V##n1[2], V##n1[3]} + acc2B; \
                accA = accA + acc2A; accB = accB + acc2B; \
                float sA = accA.x + accA.y, sB = accB.x + accB.y; \
                sA = DPP_ADD(sA, 0xB1); sB = DPP_ADD(sB, 0xB1); sA = DPP_ADD(sA, 0x4E); sB = DPP_ADD(sB, 0x4E); sA = DPP_ADD(sA, 0x141); sB = DPP_ADD(sB, 0x141); \
                const f32x2 saA = {sA, sA}, saB = {sB, sB}, vA = {V##va, V##va}, vB = {V##vb, V##vb}; \
                const f32x2 e_0 = {V##e0[0], V##e0[1]}, e_1 = {V##e0[2], V##e0[3]}, e_2 = {V##e1[0], V##e1[1]}, e_3 = {V##e1[2], V##e1[3]}; \
                const f32x2 k_0 = {V##k0[0], V##k0[1]}, k_1 = {V##k0[2], V##k0[3]}, k_2 = {V##k1[0], V##k1[1]}, k_3 = {V##k1[2], V##k1[3]}; \
                const f32x2 d_0 = {V##d0[0], V##d0[1]}, d_1 = {V##d0[2], V##d0[3]}, d_2 = {V##d1[0], V##d1[1]}, d_3 = {V##d1[2], V##d1[3]}; \
                f32x2 tA0 = saA * e_0, tB0 = saB * e_0, tA1 = saA * e_1, tB1 = saB * e_1, tA2 = saA * e_2, tB2 = saB * e_2, tA3 = saA * e_3, tB3 = saB * e_3; \
                tA0 = vA * k_0 + tA0; tB0 = vB * k_0 + tB0; tA1 = vA * k_1 + tA1; tB1 = vB * k_1 + tB1; tA2 = vA * k_2 + tA2; tB2 = vB * k_2 + tB2; tA3 = vA * k_3 + tA3; tB3 = vB * k_3 + tB3; \
                S[0] = S[0] * d_0 + tA0; S[4] = S[4] * d_0 + tB0; S[1] = S[1] * d_1 + tA1; S[5] = S[5] * d_1 + tB1; S[2] = S[2] * d_2 + tA2; S[6] = S[6] * d_2 + tB2; S[3] = S[3] * d_3 + tA3; S[7] = S[7] * d_3 + tB3; \
                f32x2 yA = S[0] * (f32x2){V##r0[0], V##r0[1]}, yB = S[4] * (f32x2){V##r0[0], V##r0[1]}; \
                f32x2 y2A = S[2] * (f32x2){V##r1[0], V##r1[1]}, y2B = S[6] * (f32x2){V##r1[0], V##r1[1]}; \
                yA = S[1] * (f32x2){V##r0[2], V##r0[3]} + yA; yB = S[5] * (f32x2){V##r0[2], V##r0[3]} + yB; \
                y2A = S[3] * (f32x2){V##r1[2], V##r1[3]} + y2A; y2B = S[7] * (f32x2){V##r1[2], V##r1[3]} + y2B; \
                yA = yA + y2A; yB = yB + y2B; \
                float uA = yA.x + yA.y, uB = yB.x + yB.y; \
                uA = DPP_ADD(uA, 0xB1); uB = DPP_ADD(uB, 0xB1); uA = DPP_ADD(uA, 0x4E); uB = DPP_ADD(uB, 0x4E); uA = DPP_ADD(uA, 0x141); uB = DPP_ADD(uB, 0x141); \
                if (jg == 0) { Yc[yo] = uA; Yc[(yo) + 32] = uB; } } while (0)
            f32x4 Pd0, Pd1, Pn0, Pn1, Pe0, Pe1, Pk0, Pk1, Pr0, Pr1, Qd0, Qd1, Qn0, Qn1, Qe0, Qe1, Qk0, Qk1, Qr0, Qr1; float Pva, Pvb, Qva, Qvb;
            RW_LV(P, 0);
#pragma unroll 2
            for (int tl = 0; tl < TC; tl += 2) {
                RW_LV(Q, tl + 1);
                RW_ROW2(P, tl * 64);
                if (tl + 2 < TC) RW_LV(P, tl + 2);
                RW_ROW2(Q, (tl + 1) * 64);
            }
#undef RW_LV
#undef RW_ROW2
            __syncthreads();
        }
    } else {
        const int hw = wid - 4, tl = hw * 8 + (lane >> 3), c8 = 8 * (lane & 7), ch = 64 * h + c8;
        float mu_r[8], mu_k[8], mu_v[8], c_kk[8], c_ka[8], c_rk[8], c_gg[8], c_gb[8];
#pragma unroll
        for (int e = 0; e < 8; ++e) { mu_r[e] = PL->in[I_MU][ch + e]; mu_k[e] = PL->in[I_MU][1024 + ch + e]; mu_v[e] = PL->in[I_MU][2048 + ch + e];
            c_kk[e] = PL->in[I_KK][ch + e]; c_ka[e] = PL->in[I_KA][ch + e]; c_rk[e] = PL->in[I_RK][ch + e]; c_gg[e] = PL->in[I_GNG][ch + e]; c_gb[e] = PL->in[I_GNB][ch + e]; }
        bf16x8 pr, pk, pv, qr, qk, qv, pw, pa, pgt;
#define UNPK(v, e) bf2f((bf16_t)(v)[e])
#define RW_LOAD(chn) do { const int tg = (chn) * TC + tl; const size_t tok = (size_t)b * SEQ + tg; \
            const bf16_t* up = u + tok * ABP + 1536 + ch; pr = *(const bf16x8*)up; pk = *(const bf16x8*)(up + 1024); pv = *(const bf16x8*)(up + 2048); \
            if (tg > 0) { qr = *(const bf16x8*)(up - ABP); qk = *(const bf16x8*)(up + 1024 - ABP); qv = *(const bf16x8*)(up + 2048 - ABP); } \
            else { _Pragma("unroll") for (int e = 0; e < 8; ++e) { qr[e] = 0; qk[e] = 0; qv[e] = 0; } } \
            const bf16_t* lp = lo + tok * 3072 + ch; pw = *(const bf16x8*)lp; pa = *(const bf16x8*)(lp + 1024); pgt = *(const bf16x8*)(lp + 2048); } while (0)
#define RW_PREP(chn) do { LAS float* a_ = A + ((chn) & 1) * TC * 384 + tl * 384 + c8; LAS float* g_ = Gb + ((chn) & 1) * TC * 64 + tl * 64 + c8; LAS float* Bc = BON + ((chn) & 1) * TC; \
            float xr[8], kp[8], kkv[8], av[8], o0[8], o1[8], o2[8], o5[8], gg[8]; float s1 = 0.f, s2 = 0.f; \
            _Pragma("unroll") for (int e = 0; e < 8; ++e) { const float r0 = UNPK(pr, e), k0 = UNPK(pk, e), v0 = UNPK(pv, e); \
                xr[e] = r0 + (UNPK(qr, e) - r0) * mu_r[e]; const float xk = k0 + (UNPK(qk, e) - k0) * mu_k[e]; o5[e] = v0 + (UNPK(qv, e) - v0) * mu_v[e]; \
                av[e] = UNPK(pa, e); gg[e] = UNPK(pgt, e); o0[e] = fexp2(UNPK(pw, e) * LOG2E); \
                kkv[e] = xk * c_kk[e]; s1 += kkv[e] * kkv[e]; kp[e] = xk * (1.f + (av[e] - 1.f) * c_ka[e]); s2 += xr[e] * kp[e] * c_rk[e]; } \
            s1 = red8(s1); s2 = red8(s2); const float rn = 1.f / fmaxf(sqrtf(s1), 1e-12f); \
            _Pragma("unroll") for (int e = 0; e < 8; ++e) { const float kkn = kkv[e] * rn; o1[e] = -kkn; o2[e] = kkn * av[e]; } \
            *(LAS f32x4*)(a_) = (f32x4){o0[0], o0[1], o0[2], o0[3]}; *(LAS f32x4*)(a_ + 4) = (f32x4){o0[4], o0[5], o0[6], o0[7]}; \
            *(LAS f32x4*)(a_ + 64) = (f32x4){o1[0], o1[1], o1[2], o1[3]}; *(LAS f32x4*)(a_ + 68) = (f32x4){o1[4], o1[5], o1[6], o1[7]}; \
            *(LAS f32x4*)(a_ + 128) = (f32x4){o2[0], o2[1], o2[2], o2[3]}; *(LAS f32x4*)(a_ + 132) = (f32x4){o2[4], o2[5], o2[6], o2[7]}; \
            *(LAS f32x4*)(a_ + 192) = (f32x4){kp[0], kp[1], kp[2], kp[3]}; *(LAS f32x4*)(a_ + 196) = (f32x4){kp[4], kp[5], kp[6], kp[7]}; \
            *(LAS f32x4*)(a_ + 256) = (f32x4){xr[0], xr[1], xr[2], xr[3]}; *(LAS f32x4*)(a_ + 260) = (f32x4){xr[4], xr[5], xr[6], xr[7]}; \
            *(LAS f32x4*)(a_ + 320) = (f32x4){o5[0], o5[1], o5[2], o5[3]}; *(LAS f32x4*)(a_ + 324) = (f32x4){o5[4], o5[5], o5[6], o5[7]}; \
            *(LAS f32x4*)(g_) = (f32x4){gg[0], gg[1], gg[2], gg[3]}; *(LAS f32x4*)(g_ + 4) = (f32x4){gg[4], gg[5], gg[6], gg[7]}; \
            if ((lane & 7) == 0) Bc[tl] = s2; } while (0)
#define RW_POST(chn) do { const LAS float* a_ = A + ((chn) & 1) * TC * 384 + tl * 384 + 320 + c8; const LAS float* g_ = Gb + ((chn) & 1) * TC * 64 + tl * 64 + c8; \
            const LAS float* y_ = Yb + ((chn) & 1) * TC * 64 + tl * 64 + c8; const float bon = BON[((chn) & 1) * TC + tl]; \
            const f32x4 y0 = *(const LAS f32x4*)(y_), y1 = *(const LAS f32x4*)(y_ + 4), v0 = *(const LAS f32x4*)(a_), v1 = *(const LAS f32x4*)(a_ + 4), g0 = *(const LAS f32x4*)(g_), g1 = *(const LAS f32x4*)(g_ + 4); \
            float yy[8] = {y0[0], y0[1], y0[2], y0[3], y1[0], y1[1], y1[2], y1[3]}; const float vv[8] = {v0[0], v0[1], v0[2], v0[3], v1[0], v1[1], v1[2], v1[3]}; const float gq[8] = {g0[0], g0[1], g0[2], g0[3], g1[0], g1[1], g1[2], g1[3]}; \
            float sm = 0.f; _Pragma("unroll") for (int e = 0; e < 8; ++e) sm += yy[e]; const float mean = red8(sm) * (1.f / 64.f); \
            float sv = 0.f; _Pragma("unroll") for (int e = 0; e < 8; ++e) { yy[e] -= mean; sv += yy[e] * yy[e]; } const float rsd = __builtin_amdgcn_rsqf(red8(sv) * (1.f / 64.f) + 64e-5f); \
            float ov[8]; _Pragma("unroll") for (int e = 0; e < 8; ++e) ov[e] = (yy[e] * rsd * c_gg[e] + c_gb[e] + bon * vv[e]) * gq[e]; \
            u32x4 w; w.x = cvt_pk_bf16(ov[0], ov[1]); w.y = cvt_pk_bf16(ov[2], ov[3]); w.z = cvt_pk_bf16(ov[4], ov[5]); w.w = cvt_pk_bf16(ov[6], ov[7]); \
            *(u32x4*)(y + ((size_t)b * SEQ + (chn) * TC + tl) * DM + 1024 + ch) = w; } while (0)
        RW_LOAD(0); RW_PREP(0);
        __syncthreads();
        for (int chn = 0; chn < NC; ++chn) {
            if (chn + 1 < NC) RW_LOAD(chn + 1);
            if (chn > 0) RW_POST(chn - 1);
            if (chn + 1 < NC) RW_PREP(chn + 1);
            __syncthreads();
        }
        RW_POST(NC - 1);
#undef RW_LOAD
#undef RW_PREP
#undef RW_POST
#undef UNPK
    }
    __syncthreads();
}

#define XB_TMO      128
#define XB_XCNT(j)  (256  + 64 * (j))
#define XB_XSUB(j)  (1280 + 64 * (j))
#define XB_XGEN(j)  (2304 + 64 * (j))
#define XB_TOP      3328
#define XB_TOPGEN   3392
#define XCD_BAR_WORDS 3456
#define XB_SPIN_CAP (1u << 18)

__device__ __forceinline__ unsigned xb_ld(unsigned* p)              { return __hip_atomic_load(p, __ATOMIC_RELAXED, __HIP_MEMORY_SCOPE_AGENT); }
__device__ __forceinline__ unsigned xb_add(unsigned* p, unsigned v) { return __hip_atomic_fetch_add(p, v, __ATOMIC_RELAXED, __HIP_MEMORY_SCOPE_AGENT); }
__device__ __forceinline__ unsigned xb_xcc_id() { return (unsigned)__builtin_amdgcn_s_getreg((3 << 11) | 20) & 0xFu; }
#define XB_SPIN(cond, bar) do { unsigned _sp = 0; while (cond) { __builtin_amdgcn_s_sleep(1); \
    if ((++_sp & 255u) == 0u) { if (xb_ld(&(bar)[XB_TMO])) break; if (_sp > XB_SPIN_CAP) { atomicAdd(&(bar)[XB_TMO], 1u); break; } } } } while (0)

struct XcdBarrier {
    unsigned* bar; unsigned x;
    volatile LAS unsigned* st;
};

__device__ __forceinline__ XcdBarrier xcd_barrier_post(unsigned* bar, volatile LAS unsigned* st) {
    XcdBarrier b; b.bar = bar; b.x = xb_xcc_id(); b.st = st;
    if (threadIdx.x == 0) (void)xb_add(&bar[XB_XCNT(b.x)], 1u);
    return b;
}
__device__ __forceinline__ void xcd_barrier_complete(unsigned* bar, unsigned x, unsigned& nloc, unsigned& nx) {
    const unsigned G = gridDim.x * gridDim.y * gridDim.z;
    unsigned sum, cnt, mine, sp = 0u;
    for (;;) {
        sum = 0u; cnt = 0u; mine = 0u;
#pragma unroll
        for (unsigned j = 0; j < 16; ++j) { const unsigned c = xb_ld(&bar[XB_XCNT(j)]); sum += c; cnt += (c > 0u) ? 1u : 0u; mine = (j == x) ? c : mine; }
        if (sum == G) break;
        __builtin_amdgcn_s_sleep(1);
        if ((++sp & 255u) == 0u) { if (xb_ld(&bar[XB_TMO])) break; if (sp > XB_SPIN_CAP) { atomicAdd(&bar[XB_TMO], 1u); break; } }
    }
    nloc = mine > 0u ? mine : 1u; nx = cnt > 0u ? cnt : 1u;
}

__device__ __forceinline__ void xcd_barrier(const XcdBarrier& b) {
    asm volatile("s_waitcnt vmcnt(0)" ::: "memory");
    __syncthreads();
    if (threadIdx.x == 0) {
        unsigned* bar = b.bar;
        __builtin_amdgcn_s_waitcnt(0);
        unsigned nloc = b.st[0], nx = b.st[1];
        if (nloc == 0u) { xcd_barrier_complete(bar, b.x, nloc, nx); b.st[0] = nloc; b.st[1] = nx; }
        const unsigned old = xb_add(&bar[XB_XSUB(b.x)], 1u);
        const unsigned gen = old / nloc;
        if (old + 1u == (gen + 1u) * nloc) {
            __builtin_amdgcn_fence(__ATOMIC_RELEASE, "agent");
            asm volatile("s_waitcnt vmcnt(0)" ::: "memory");
            const unsigned og = xb_add(&bar[XB_TOP], 1u);
            const unsigned tg = og / nx;
            if (og + 1u == (tg + 1u) * nx) xb_add(&bar[XB_TOPGEN], 1u);
            else XB_SPIN(xb_ld(&bar[XB_TOPGEN]) == tg, bar);
            __builtin_amdgcn_fence(__ATOMIC_ACQUIRE, "agent");
            xb_add(&bar[XB_XGEN(b.x)], 1u);
            asm volatile("s_waitcnt vmcnt(0)" ::: "memory");
        } else {
            XB_SPIN(xb_ld(&bar[XB_XGEN(b.x)]) == gen, bar);
            __builtin_amdgcn_fence(__ATOMIC_ACQUIRE, "agent");
            asm volatile("s_waitcnt vmcnt(0)" ::: "memory");
        }
    }
    __syncthreads();
}

#ifndef EN_MASK
#define EN_MASK 0xFFFF
#endif
#define EN(b) ((EN_MASK >> (b)) & 1)
__global__ void __launch_bounds__(NTHREADS, 2) hybrid_fwd(Params P) {
    extern __shared__ __attribute__((aligned(16))) unsigned char lds_raw[];
    LAS unsigned char* lds = (LAS unsigned char*)lds_raw;
    cg::grid_group grid = cg::this_grid();
    const int tid0 = threadIdx.x, G0 = gridDim.x, bx0 = blockIdx.x;
    LAS Params* PLw = (LAS Params*)(lds + LDS_BYTES - 1024);
    for (int i = tid0; i < (int)(sizeof(Params) / 4); i += NTHREADS) ((LAS unsigned*)PLw)[i] = ((const unsigned*)&P)[i];
    __syncthreads();
    const LAS Params* PL = PLw;
    const int ph_lo = P.ph_lo, ph_hi = P.ph_hi;
    volatile LAS unsigned* bst = (volatile LAS unsigned*)(lds + LDS_BYTES - 1024 + 512);
    if (tid0 < 2) bst[tid0] = 0u;
    __syncthreads();
    XcdBarrier xbar = xcd_barrier_post((unsigned*)(P.ws + WS_BAR), bst);
#ifndef REP_MASK
#define REP_MASK 0
#endif
    unsigned rep_mask = REP_MASK; (void)rep_mask;
    for (int ph = ph_lo; ph < ph_hi; ++ph) {
#define ROOTS int tid = tid0, G = G0, bx = bx0; unsigned char* ws = P.ws; \
        asm volatile("" : "+v"(tid)); asm volatile("" : "+s"(G)); asm volatile("" : "+s"(bx)); asm volatile("" : "+s"(ws)); \
        const int lane = tid & 63, wave = __builtin_amdgcn_readfirstlane(tid >> 6); const int gw = bx * 8 + wave, NGW = G * 8; \
        ssq_t* ssb = (ssq_t*)(ws + WS_SS); f32x2* cs64 = (f32x2*)(ws + WS_CS64); f32x2* cs32 = (f32x2*)(ws + WS_CS32); bf16_t* xb = (bf16_t*)(ws + WS_XB); unsigned char* big = ws + WS_BIG; \
        (void)lane; (void)gw; (void)NGW; (void)ssb; (void)cs64; (void)cs32; (void)xb; (void)big;
        const int L = ph >= 14 ? 1 : 0;
        int kind = 0, nsub = 1;
        if (ph == 1 || ph == 4 || ph == 9 || ph == 16 || ph == 17 || ph == 21) kind = 1;
        if (ph == 2 || ph == 12 || ph == 14 || ph == 24) kind = 2;
        if (ph == 3 || ph == 8 || ph == 11 || ph == 13 || ph == 15 || ph == 20 || ph == 23 || ph == 25) kind = 3;
        if (ph == 6) kind = 4;
        if (ph == 17) nsub = 2;

        if (EN(0) && ph == 0) { ROOTS
            for (int i = bx * NTHREADS + tid; i < MT * 10; i += G * NTHREADS) { const int bsel = i / MT; const int bi = bsel < 9 ? 1 + bsel : SS_DUMMY; ssb[(size_t)bi * MT + (i % MT)] = 0u; }
            LAS float* scr = (LAS float*)(lds + wave * 16384);
            conv_ffn(PL, 0, 0, scr, lane, gw, NGW);
            conv_ffn(PL, 0, 1, scr, lane, gw, NGW);
            conv_matrix(PL->in[I_ABIN], DM, ABN, PL->in[I_MIXN], (bf16_t*)(ws + WS_WABIN), DM, 0, 0, scr, lane, gw, NGW);
            conv_matrix(PL->in[I_ABOUT], DM, DM, nullptr, (bf16_t*)(ws + WS_WABOUT), DM, 0, 0, scr, lane, gw, NGW);
            conv_matrix(PL->in[I_CDIN], DM, CDN, PL->in[I_MIXN] + DM, (bf16_t*)(ws + WS_WCDIN), DM, 0, 0, scr, lane, gw, NGW);
            conv_matrix(PL->in[I_CDOUT], DM, DM, nullptr, (bf16_t*)(ws + WS_WCDOUT), DM, 0, 0, scr, lane, gw, NGW);
            conv_matrix(PL->in[I_WUQ], 512, 1536, PL->in[I_CQN], (bf16_t*)(ws + WS_WUQ), 512, 0, 0, scr, lane, gw, NGW);
            conv_matrix(PL->in[I_WUKV], 256, 2048, PL->in[I_CKVN], (bf16_t*)(ws + WS_WUKV), 256, 0, 0, scr, lane, gw, NGW);
            for (int l2 = 0; l2 < 2; ++l2) {
                conv_matrix(PL->in[I_MXWQ] + (size_t)l2 * DM * 512, DM, 512, PL->in[I_MXN] + l2 * DM, (bf16_t*)(ws + WS_WMQ) + (size_t)l2 * 512 * DM, DM, 0, 0, scr, lane, gw, NGW);
                conv_matrix(PL->in[I_MXWO] + (size_t)l2 * 512 * DM, 512, DM, nullptr, (bf16_t*)(ws + WS_WMO) + (size_t)l2 * DM * 512, 512, 0, 0, scr, lane, gw, NGW);
            }
            conv_matrix(PL->in[I_MEMWKV], DM, 1024, PL->in[I_MEMN], (bf16_t*)(ws + WS_WMKV), DM, 0, 0, scr, lane, gw, NGW);
            { bf16_t* wl = (bf16_t*)(ws + WS_WLORA);
              for (int i = bx * NTHREADS + tid; i < 3072 * 512; i += G * NTHREADS) { const int n = i >> 9, k = i & 511; float v = 0.f;
                  if (n < 1024) { if (k < 64) v = PL->in[I_W2][k * 1024 + n]; }
                  else if (n < 2048) { if (k >= 128 && k < 192) v = PL->in[I_A2][(k - 128) * 1024 + n - 1024]; }
                  else { if (k >= 256 && k < 416) v = PL->in[I_G2][(k - 256) * 1024 + n - 2048]; }
                  wl[i] = f2bf(v); } }
            for (int row = gw; row < MT; row += NGW) row_to_bf16(PL->in[I_X] + (size_t)row * DM, xb + (size_t)row * DM, ssb + (size_t)SS_A0 * MT + row, lane);
            for (int row = gw; row < NB * MEML; row += NGW) row_to_bf16(PL->in[I_MEM] + (size_t)row * DM, (bf16_t*)(ws + WS_MEMB) + (size_t)row * DM, ssb + (size_t)SS_MEM * MT + row, lane);
            { const int* pos = (const int*)PL->in[I_POS];
              for (int i = bx * NTHREADS + tid; i < MT * 48; i += G * NTHREADS) { const int tok = i / 48, j = i % 48; const bool big64 = j < 32; const int fi = big64 ? j : j - 32;
                  const float e = big64 ? (float)(2 * fi) / 64.f : (float)(2 * fi) / 32.f;
                  const float inv = 1.0f / powf(10000.0f, e);
                  const float ang = (float)pos[tok] * inv;
                  const double rev = (double)ang * 0.15915494309189535; const float fr = (float)(rev - rint(rev));
                  const f32x2 t = {__builtin_amdgcn_cosf(fr), __builtin_amdgcn_sinf(fr)};
                  if (big64) cs64[(size_t)tok * 32 + fi] = t; else cs32[(size_t)tok * 16 + fi] = t; } }
        }
        if (EN(1) && ph == 2) { ROOTS
            bf16_t* mkv = (bf16_t*)(ws + WS_MEMKV);
            for (int it = gw; it < NB * MEML * 4; it += NGW) { const int row = it >> 2, hd = it & 3; bf16_t* p = mkv + (size_t)row * 1024 + hd * 128;
                const float x0 = bf2f(p[lane]), x1 = bf2f(p[64 + lane]); const float ss = wave_sum(x0 * x0 + x1 * x1); const float rs = __builtin_amdgcn_rsqf(ss / 128.f + EPS);
                p[lane] = f2bf(x0 * rs * PL->in[I_MEMKN][lane]); p[64 + lane] = f2bf(x1 * rs * PL->in[I_MEMKN][64 + lane]); }
            __syncthreads();
        }
        for (int sub = 0; sub < nsub; ++sub) {
            if (kind == 0) break;
            ROOTS
            pg8::Gemm g; pg8::EpiAny E; E.kind = kind; E.perm = (kind != 3); E.O = nullptr; E.ldc = 0; E.ss = nullptr; E.inv_k = 1.f / DM; E.p0 = nullptr; E.p1 = nullptr;
            if (kind == 1) {
                if (ph == 1) { g = {(const bf16_t*)(ws + WS_MEMB), (const bf16_t*)(ws + WS_WMKV), NB * MEML, 1024, DM, DM}; E.O = (bf16_t*)(ws + WS_MEMKV); E.ldc = 1024; E.ss = ssb + (size_t)SS_MEM * MT; }
                else if (ph == 4) { g = {xb, (const bf16_t*)(ws + WS_WABIN), MT, ABP, DM, DM}; E.O = (bf16_t*)(big + B0_U); E.ldc = ABP; E.ss = ssb + (size_t)SS_B0 * MT; }
                else if (ph == 16) { g = {xb, (const bf16_t*)(ws + WS_WCDIN), MT, CDP, DM, DM}; E.O = (bf16_t*)(big + B1_U); E.ldc = CDP; E.ss = ssb + (size_t)SS_B1 * MT; E.p0 = ssb + (size_t)SS_CQ * MT; E.p1 = ssb + (size_t)SS_CKV * MT; }
                else if (ph == 17 && sub == 0) { g = {(const bf16_t*)(big + B1_U), (const bf16_t*)(ws + WS_WUQ), MT, 1536, 512, CDP}; E.O = (bf16_t*)(big + B1_Q); E.ldc = 1536; E.ss = ssb + (size_t)SS_CQ * MT; E.inv_k = 1.f / 512.f; }
                else if (ph == 17) { g = {(const bf16_t*)(big + B1_U) + 512, (const bf16_t*)(ws + WS_WUKV), MT, 2048, 256, CDP}; E.O = (bf16_t*)(big + B1_KV); E.ldc = 2048; E.ss = ssb + (size_t)SS_CKV * MT; E.inv_k = 1.f / 256.f; }
                else { g = {xb, (const bf16_t*)(ws + WS_WMQ) + (size_t)L * 512 * DM, MT, 512, DM, DM}; E.O = (bf16_t*)(big + BM_Q); E.ldc = 512; E.ss = ssb + (size_t)(L ? SS_C1 : SS_C0) * MT; }
            } else if (kind == 2) {
                const bool second = (ph == 12 || ph == 24);
                g = {xb, (const bf16_t*)(ws + (ph == 24 ? WS_WGUC : second ? WS_WGUB : WS_WGUA)), MT, 2 * FF, DM, DM};
                E.O = (bf16_t*)(big + B_H); E.ldc = FF;
                E.ss = ssb + (size_t)(ph == 2 ? SS_A0 : ph == 12 ? SS_D0 : ph == 14 ? SS_A1 : SS_D1) * MT;
            } else if (kind == 3) {
                float* outp = PL->out;
                E.ss = outp; E.p0 = outp; E.O = xb; E.ldc = DM; E.inv_k = 1.f;
                if (ph == 3 || ph == 15) { g = {(const bf16_t*)(big + B_H), (const bf16_t*)(ws + WS_WDA), MT, DM, FF, FF}; E.inv_k = 0.5f; E.p1 = ssb + (size_t)(ph == 3 ? SS_B0 : SS_B1) * MT; if (ph == 3) E.ss = PL->in[I_X]; }
                else if (ph == 13 || ph == 25) { g = {(const bf16_t*)(big + B_H), (const bf16_t*)(ws + (ph == 25 ? WS_WDC : WS_WDB)), MT, DM, FF, FF}; E.inv_k = 0.5f; E.p1 = ssb + (size_t)(ph == 13 ? SS_A1 : SS_DUMMY) * MT; if (ph == 25) E.O = nullptr; }
                else if (ph == 8) { g = {(const bf16_t*)(big + B0_Y), (const bf16_t*)(ws + WS_WABOUT), MT, DM, DM, DM}; E.p1 = ssb + (size_t)SS_C0 * MT; }
                else if (ph == 20) { g = {(const bf16_t*)(big + B1_Y), (const bf16_t*)(ws + WS_WCDOUT), MT, DM, DM, DM}; E.p1 = ssb + (size_t)SS_C1 * MT; }
                else { g = {(const bf16_t*)(big + BM_O), (const bf16_t*)(ws + WS_WMO) + (size_t)L * DM * 512, MT, DM, 512, 512}; E.p1 = ssb + (size_t)(L ? SS_D1 : SS_D0) * MT; }
            } else {
                g = {(const bf16_t*)(big + B0_LIN), (const bf16_t*)(ws + WS_WLORA), MT, 3072, 512, 512};
                E.O = (bf16_t*)(big + B0_LOUT); E.ldc = 3072; E.p0 = (void*)PL->in[I_W0]; E.p1 = (void*)PL->in[I_A0];
            }
#if REP_MASK
            if (kind == 3 && ((rep_mask >> ph) & 1u)) { E.inv_k = 0.f; E.p1 = ssb + (size_t)SS_DUMMY * MT; }
#endif
            pg8::StaticOrder S; S.init(g.M, g.N, G, bx);
            pg8::gemm_phase<pg8::EpiAny, pg8::StaticOrder, true, true>(lds, g, S, E, tid);
        }
        if (EN(6) && ph == 5) { ROOTS
            bf16_t* u = (bf16_t*)(big + B0_U);
            for (int tok = gw; tok < MT; tok += NGW) { bf16_t* p = u + (size_t)tok * ABP; const f32x2* c64 = cs64 + (size_t)tok * 32;
                norm_rope_row<64>(p + 1024, 64, 4, PL->in[I_SWAKN], c64, lane); }
            { bf16_t* lin = (bf16_t*)(big + B0_LIN);
              int dcol, kindc = 0; const int s8 = 8 * lane;
              if (lane < 36) { dcol = s8 < 64 ? s8 : (s8 < 128 ? 128 + (s8 - 64) : 256 + (s8 - 128)); kindc = s8 < 64 ? 0 : (s8 < 128 ? 1 : 2); }
              else { const int pz = lane - 36; dcol = pz < 8 ? 64 + 8 * pz : (pz < 16 ? 192 + 8 * (pz - 8) : 416 + 8 * (pz - 16)); }
              float mu8[8];
#pragma unroll
              for (int e = 0; e < 8; ++e) mu8[e] = lane < 36 ? PL->in[I_MU][3072 + s8 + e] : 0.f;
              for (int tok = gw; tok < MT; tok += NGW) {
                  u32x4 w = {0u, 0u, 0u, 0u};
                  if (lane < 36) { const bf16_t* up = u + (size_t)tok * ABP + 4608 + s8; const bf16x8 pc = *(const bf16x8*)up; bf16x8 pp;
                      if ((tok % SEQ) != 0) pp = *(const bf16x8*)(up - ABP); else {
#pragma unroll
                          for (int e = 0; e < 8; ++e) pp[e] = 0; }
                      float v[8];
#pragma unroll
                      for (int e = 0; e < 8; ++e) { const float c0 = bf2f((bf16_t)pc[e]); const float xs = c0 + (bf2f((bf16_t)pp[e]) - c0) * mu8[e];
                          v[e] = kindc == 0 ? tanhf(xs) : (kindc == 1 ? xs : 1.f / (1.f + __expf(-xs))); }
                      w.x = cvt_pk_bf16(v[0], v[1]); w.y = cvt_pk_bf16(v[2], v[3]); w.z = cvt_pk_bf16(v[4], v[5]); w.w = cvt_pk_bf16(v[6], v[7]); }
                  *(u32x4*)(lin + (size_t)tok * 512 + dcol) = w; } }
        }
        if (EN(7) && ph == 7) { ROOTS
            const int nscan = G / 2;
            if (EN(8) && bx < nscan) { for (int un = bx; un < NB * 16; un += nscan) rwkv_unit(lds, PL, un >> 4, un & 15, tid); }
            else {
                const bf16_t* u = (const bf16_t*)(big + B0_U); bf16_t* y = (bf16_t*)(big + B0_Y);
                const int nsw = G - nscan; const int vsw = ((nsw & 7) == 0 && (nscan & 7) == 0) ? ((bx & 7) * (nsw >> 3) + ((bx - nscan) >> 3)) : (bx - nscan);
                for (int un = vsw; un < NB * 16 * 8; un += nsw) { const int qb = un & 7, hd = (un >> 3) & 15, b = un >> 7;
                    AttSrc s; s.q = u + (size_t)b * SEQ * ABP + hd * 64; s.qp = ABP; s.ka = u + (size_t)b * SEQ * ABP + 1024 + (hd >> 2) * 64; s.kap = ABP; s.kb = s.ka; s.kbp = ABP;
                    s.v = u + (size_t)b * SEQ * ABP + 1280 + (hd >> 2) * 64; s.vp = ABP; s.SK = SEQ;
                    f32x16 o[2];
                    s.qcs = cs64 + (size_t)b * SEQ * 32;
                    attn_unit<64, 0, 64, 1>(lds, s, qb * 256, 0.125f * LOG2E, PL->in[I_SINKS][hd] * LOG2E, PL->in[I_SWAQN], o, tid);
                    attn_store<64>(o, y + ((size_t)b * SEQ + qb * 256 + wave * 32 + (lane & 31)) * DM + hd * 64, lane >> 5); }
                const int gw2 = (bx - nscan) * 8 + wave, NGW2 = (G - nscan) * 8;
                conv_ffn(PL, 1, 0, (LAS float*)(lds + wave * 16384), lane, gw2, NGW2);
                conv_ffn(PL, 1, 1, (LAS float*)(lds + wave * 16384), lane, gw2, NGW2);
            }
        }
        if (EN(9) && (ph == 10 || ph == 22)) { ROOTS
            const bf16_t* mq = (const bf16_t*)(big + BM_Q); bf16_t* mo = (bf16_t*)(big + BM_O);
            const int vbm = (G & 7) == 0 ? ((bx & 7) * (G >> 3) + (bx >> 3)) : bx;
            for (int un = vbm; un < NB * 4 * 8; un += G) { const int qb = un & 7, hd = (un >> 3) & 3, b = un >> 5;
                AttSrc s; s.q = mq + (size_t)b * SEQ * 512 + hd * 128; s.qp = 512; s.ka = (const bf16_t*)(ws + WS_MEMKV) + (size_t)b * MEML * 1024 + hd * 128; s.kap = 1024; s.kb = s.ka; s.kbp = 1024;
                s.v = (const bf16_t*)(ws + WS_MEMKV) + (size_t)b * MEML * 1024 + 512 + hd * 128; s.vp = 1024; s.SK = MEML;
                f32x16 o[4];
                attn_unit<128, 0, 128, 2>(lds, s, qb * 256, 0.08838834764831845f * LOG2E, 0.f, PL->in[I_MXQN] + L * 128, o, tid);
                attn_store<128>(o, mo + ((size_t)b * SEQ + qb * 256 + wave * 32 + (lane & 31)) * 512 + hd * 128, lane >> 5); }
        }
        if (EN(10) && ph == 18) { ROOTS
            bf16_t* u = (bf16_t*)(big + B1_U); bf16_t* q = (bf16_t*)(big + B1_Q); bf16_t* kv = (bf16_t*)(big + B1_KV);
            for (int tok = gw; tok < MT; tok += NGW) { const f32x2* c64 = cs64 + (size_t)tok * 32; const f32x2* c32 = cs32 + (size_t)tok * 16;
                norm_rope_row<64>(kv + (size_t)tok * 2048, 128, 16, PL->in[I_KNOPEN], nullptr, lane);
                norm_rope_row<32>(u + (size_t)tok * CDP + 768, 32, 1, PL->in[I_KROPEN], c32, lane);
                norm_rope_row<64>(u + (size_t)tok * CDP + 800, 64, 16, PL->in[I_DQN], c64, lane);
                norm_rope_row<64>(u + (size_t)tok * CDP + 1824, 64, 16, PL->in[I_DKN], c64, lane); }
        }
        if (EN(11) && ph == 19) { ROOTS
            const bf16_t* u = (const bf16_t*)(big + B1_U); const bf16_t* q = (const bf16_t*)(big + B1_Q); const bf16_t* kv = (const bf16_t*)(big + B1_KV); bf16_t* y = (bf16_t*)(big + B1_Y);
            const int vb = (G & 7) == 0 ? ((bx & 7) * (G >> 3) + (bx >> 3)) : bx;
            for (int un = vb; un < NB * 16 * 8; un += G) {
                int bh, qb;
                if (G == 256) { const int i = un >> 8; bh = vb >> 1; const int base = (vb & 1) ? 1 : 0; qb = (i == 0) ? base : (i == 1) ? 7 - base : (i == 2) ? 3 - base : 4 + base; }
                else { bh = un >> 3; qb = un & 7; }
                const int b = bh >> 4, hd = bh & 15;
                AttSrc s; s.q = q + (size_t)b * SEQ * 1536 + hd * 96; s.qp = 1536; s.ka = kv + (size_t)b * SEQ * 2048 + hd * 128; s.kap = 2048; s.kb = u + (size_t)b * SEQ * CDP + 768; s.kbp = CDP;
                s.v = kv + (size_t)b * SEQ * 2048 + hd * 128 + 64; s.vp = 2048; s.SK = SEQ;
                f32x16 o[2];
                s.qcs = cs32 + (size_t)b * SEQ * 16; s.qg2 = PL->in[I_QROPEN];
                attn_unit<64, 32, 64, 0>(lds, s, qb * 256, 0.10206207261596577f * LOG2E, 0.f, PL->in[I_QNOPEN], o, tid);
                attn_store<64>(o, y + ((size_t)b * SEQ + qb * 256 + wave * 32 + (lane & 31)) * DM + hd * 64, lane >> 5);
            }
            const float lam = __expf(wave_sum(PL->in[I_LQ1][lane] * PL->in[I_LK1][lane])) - __expf(wave_sum(PL->in[I_LQ2][lane] * PL->in[I_LK2][lane])) + LAMBDA_INIT;
            if (EN(12)) for (int un = vb; un < NB * 8 * 8; un += G) {
                int bh, qb;
                if (G == 256) { const int i = un >> 8; bh = vb >> 2; qb = i == 0 ? (vb & 3) : 7 - (vb & 3); }
                else { bh = un >> 3; qb = un & 7; }
                const int b = bh >> 3, hd = bh & 7;
                AttSrc s; s.qp = CDP; s.kap = CDP; s.kbp = CDP; s.SK = SEQ; s.v = u + (size_t)b * SEQ * CDP + 2848 + hd * 128; s.vp = CDP;
                s.q = u + (size_t)b * SEQ * CDP + 800 + (2 * hd) * 64; s.ka = u + (size_t)b * SEQ * CDP + 1824 + (2 * hd) * 64; s.kb = s.ka;
                f32x16 o1[4];
                f32x4* stash = (f32x4*)(ws + WS_XB) + (size_t)bx * NTHREADS + tid;
                attn_unit<64, 0, 128, 0>(lds, s, qb * 256, 0.125f * LOG2E, 0.f, nullptr, o1, tid);
#pragma unroll
                for (int d = 0; d < 4; ++d)
#pragma unroll
                    for (int i4 = 0; i4 < 4; ++i4) stash[(size_t)(d * 4 + i4) * G * NTHREADS] = (f32x4){o1[d][4 * i4], o1[d][4 * i4 + 1], o1[d][4 * i4 + 2], o1[d][4 * i4 + 3]};
                s.q += 64; s.ka += 64; s.kb = s.ka;
                attn_unit<64, 0, 128, 0>(lds, s, qb * 256, 0.125f * LOG2E, 0.f, nullptr, o1, tid);
                float ssq = 0.f;
#pragma unroll
                for (int d = 0; d < 4; ++d)
#pragma unroll
                    for (int i4 = 0; i4 < 4; ++i4) { const f32x4 a = stash[(size_t)(d * 4 + i4) * G * NTHREADS];
#pragma unroll
                        for (int j = 0; j < 4; ++j) { const float v = a[j] - lam * o1[d][4 * i4 + j]; o1[d][4 * i4 + j] = v; ssq += v * v; }
                        if (i4 == 3) asm volatile("" ::: "memory"); }
                ssq += __shfl_xor(ssq, 32);
                const float rs = __builtin_amdgcn_rsqf(ssq / 128.f + EPS) * (1.f - LAMBDA_INIT);
                const int hh = lane >> 5;
                bf16_t* yrow = y + ((size_t)b * SEQ + qb * 256 + wave * 32 + (lane & 31)) * DM + 1024 + hd * 128;
#pragma unroll
                for (int d = 0; d < 4; ++d) {
#pragma unroll
                    for (int i4 = 0; i4 < 4; ++i4) {
                        const f32x4 g4 = *(const f32x4*)(PL->in[I_SUBLN] + 32 * d + 8 * i4 + 4 * hh);
                        u32x2 w; w.x = cvt_pk_bf16(o1[d][4 * i4] * rs * g4[0], o1[d][4 * i4 + 1] * rs * g4[1]); w.y = cvt_pk_bf16(o1[d][4 * i4 + 2] * rs * g4[2], o1[d][4 * i4 + 3] * rs * g4[3]);
                        *(u32x2*)(yrow + 32 * d + 8 * i4 + 4 * hh) = w;
                    }
                    asm volatile("" ::: "memory");
                }
            }
        }
#if REP_MASK
        if ((rep_mask >> ph) & 1u) { rep_mask &= ~(1u << ph); --ph; xcd_barrier(xbar); continue; }
#endif
        if (ph + 1 < ph_hi) { if (ph_hi > 1000) grid.sync(); else xcd_barrier(xbar); }
    }
}

#ifndef MK_PER_PHASE
#define MK_PER_PHASE 0
#endif
extern "C" void kernel_launch(void* const* d_in, const int* in_sizes, int n_in, void* d_out, int out_size, void* d_ws, size_t ws_size, hipStream_t stream) {
    static int grid = 0;
    if (grid == 0) {
        if (n_in != N_IN || out_size != MT * DM || ws_size < WS_END) { fprintf(stderr, "kernel_launch: unexpected problem (n_in %d, out %d, ws %zu, need %zu)\n", n_in, out_size, ws_size, (size_t)WS_END); grid = -1; return; }
        int dev = 0, cus = 0, per_cu = 0;
        hipGetDevice(&dev); hipDeviceGetAttribute(&cus, hipDeviceAttributeMultiprocessorCount, dev);
        if (hipFuncSetAttribute((const void*)hybrid_fwd, hipFuncAttributeMaxDynamicSharedMemorySize, LDS_BYTES) != hipSuccess) { fprintf(stderr, "kernel_launch: hipFuncSetAttribute failed\n"); grid = -1; return; }
        hipOccupancyMaxActiveBlocksPerMultiprocessor(&per_cu, (const void*)hybrid_fwd, NTHREADS, LDS_BYTES);
        (void)hipGetLastError();
        if (per_cu < 1) per_cu = 1;
        grid = cus;
        fprintf(stderr, "kernel_launch: %d CUs, occupancy %d per CU, grid %d, ws %zu\n", cus, per_cu, grid, ws_size);
    }
    if (grid < 0) return;
    (void)hipMemsetAsync((unsigned char*)d_ws + WS_BAR, 0, 16384, stream);
    Params p{};
    for (int i = 0; i < N_IN; ++i) p.in[i] = (const float*)d_in[i];
    p.out = (float*)d_out; p.ws = (unsigned char*)d_ws;
#if MK_PER_PHASE
    for (int ph = 0; ph < NPHASE; ++ph) { p.ph_lo = ph; p.ph_hi = ph + 1; hipLaunchKernelGGL(hybrid_fwd, dim3(grid), dim3(NTHREADS), LDS_BYTES, stream, p); }
#else
    p.ph_lo = 0; p.ph_hi = NPHASE;
    void* args[] = {&p};
    hipError_t e = hipLaunchCooperativeKernel((const void*)hybrid_fwd, dim3(grid), dim3(NTHREADS), args, LDS_BYTES, stream);
    if (e != hipSuccess) fprintf(stderr, "cooperative launch failed: %s (grid %d)\n", hipGetErrorString(e), grid);
#endif
}
```

```cpp
#include <hip/hip_runtime.h>
#include <hip/hip_cooperative_groups.h>
#include <cstdio>
#include <cstdint>
#include <cmath>
namespace cg = cooperative_groups;
namespace pg8 {
#define PG8_LAS __attribute__((address_space(3)))
typedef unsigned short bf16_t;
typedef short bf16x8 __attribute__((ext_vector_type(8)));
typedef float f32x4 __attribute__((ext_vector_type(4)));
typedef unsigned u32x4 __attribute__((ext_vector_type(4)));
constexpr int BM = 256, BK = 64, HALF = 128, HTB = HALF * BK * 2  , STAGE_BYTES = 8 * HTB, NXCD = 8, WGM = 8;

__host__ __device__ __forceinline__ int lds_byte(int r, int c) { const int st = (r >> 4) * 2 + (c >> 5), rr = r & 15, cc = c & 31, ob = rr * 64 + cc * 2; return st * 1024 + (ob ^ (((ob >> 9) & 1) << 5)); }
__host__ __device__ __forceinline__ void stage_rc(int b, int& R, int& C) { const int st = b / 1024, sb = b % 1024, swz = sb ^ (((sb >> 9) & 1) << 5); R = (st >> 1) * 16 + swz / 64; C = (st & 1) * 32 + (swz % 64) / 2; }
__host__ __device__ __forceinline__ int perm32(int rho) { const int n = rho >> 4, i = rho & 15; return 8 * (i >> 2) + 4 * n + (i & 3); }

struct Unit { int pm, pn; };
struct Gemm { const bf16_t* A; const bf16_t* Bt; int M, N, K, lda; };

struct StaticOrder {
    int nM, nN, nwg, G, c;
    __host__ __device__ void init(int M, int N, int G_, int c_) { nM = M / BM; nN = N / BM; nwg = nM * nN; G = G_; c = c_; }
    __host__ __device__ bool next(int i, Unit& u) const {
        const long L = (long)i * G + c; if (L >= nwg) return false;
        int wgid = (int)L; { const int q = nwg / NXCD, r = nwg % NXCD, xcd = wgid % NXCD, off = wgid / NXCD; wgid = (xcd < r ? xcd * (q + 1) : r * (q + 1) + (xcd - r) * q) + off; }
        const int nig = WGM * nN, gid = wgid / nig, fm = gid * WGM, gsz = (nM - fm) < WGM ? (nM - fm) : WGM;
        u.pm = fm + ((wgid % nig) % gsz); u.pn = (wgid % nig) / gsz; return true;
    }
    __device__ __forceinline__ void a_ready(const Unit&) const {}
    __device__ __forceinline__ void done(const Unit&) const {}
};


typedef float f32x2 __attribute__((ext_vector_type(2)));
typedef __bf16 bf16x2_t __attribute__((ext_vector_type(2)));
typedef unsigned u32x2 __attribute__((ext_vector_type(2)));
__device__ __forceinline__ unsigned cvt_pk_bf16(float lo, float hi) { f32x2 v = {lo, hi}; bf16x2_t b = __builtin_convertvector(v, bf16x2_t); return __builtin_bit_cast(unsigned, b); }
constexpr float RMS_EPS = 1e-6f;
typedef unsigned ssq_t;
constexpr float SSQ_SCALE = 4096.f, SSQ_INV = 1.f / 4096.f;
__device__ __forceinline__ void ssq_add(ssq_t* p, float q) { atomicAdd(p, (ssq_t)(q * SSQ_SCALE + 0.5f)); }
__device__ __forceinline__ float ssq_rs(const ssq_t* p, float inv_k) { return __builtin_amdgcn_rsqf((float)(*p) * (inv_k * SSQ_INV) + RMS_EPS); }

struct EpiStore {
    static constexpr bool PERM = true, AFTER_DRAIN = false;
    bf16_t* O; int ldc; const ssq_t* ss; float inv_k; ssq_t* sq0; ssq_t* sq1;
    __device__ __forceinline__ void operator()(const f32x4 (&acc)[2][2][4][2], const Unit& u, int wr, int wc, int fr, int fq) const {
        const int row0 = u.pm * BM + wr * 64 + fr, col0 = u.pn * BM + wc * 32 + 8 * fq;
        ssq_t* sq = sq0 ? (u.pn < 2 ? sq0 : (u.pn == 2 ? sq1 : nullptr)) : nullptr;
#pragma unroll
        for (int ai = 0; ai < 2; ++ai)
#pragma unroll
            for (int m = 0; m < 4; ++m) {
                const int row = row0 + ai * HALF + m * 16;
                const float rs = ss ? ssq_rs(ss + row, inv_k) : 1.f;
                float q = 0.f;
#pragma unroll
                for (int bj = 0; bj < 2; ++bj) {
                    const f32x4 v0 = acc[ai][bj][m][0] * rs, v1 = acc[ai][bj][m][1] * rs;
                    q += (v0[0] * v0[0] + v0[1] * v0[1]) + (v0[2] * v0[2] + v0[3] * v0[3]) + (v1[0] * v1[0] + v1[1] * v1[1]) + (v1[2] * v1[2] + v1[3] * v1[3]);
                    u32x4 w; w.x = cvt_pk_bf16(v0[0], v0[1]); w.y = cvt_pk_bf16(v0[2], v0[3]); w.z = cvt_pk_bf16(v1[0], v1[1]); w.w = cvt_pk_bf16(v1[2], v1[3]);
                    *(u32x4*)(O + (size_t)row * ldc + col0 + bj * HALF) = w;
                }
                if (sq) { q += __shfl_xor(q, 16); q += __shfl_xor(q, 32); if (fq == 0) ssq_add(sq + row, q); }
            }
    }
};
struct EpiLora {
    static constexpr bool PERM = true, AFTER_DRAIN = false;
    bf16_t* O; int ldc; const float* w0; const float* a0;
    __device__ __forceinline__ void operator()(const f32x4 (&acc)[2][2][4][2], const Unit& u, int wr, int wc, int fr, int fq) const {
        const int row0 = u.pm * BM + wr * 64 + fr, col0 = u.pn * BM + wc * 32 + 8 * fq;
        const int kind = u.pn >> 2;
#pragma unroll
        for (int bj = 0; bj < 2; ++bj) {
            const int c = col0 + bj * HALF;
            float bias[8];
#pragma unroll
            for (int j = 0; j < 8; ++j) bias[j] = kind == 0 ? w0[c + j] : (kind == 1 ? a0[c - 1024 + j] : 0.f);
#pragma unroll
            for (int ai = 0; ai < 2; ++ai)
#pragma unroll
                for (int m = 0; m < 4; ++m) {
                    const int row = row0 + ai * HALF + m * 16;
                    float v[8];
#pragma unroll
                    for (int j = 0; j < 8; ++j) {
                        const float t = acc[ai][bj][m][j >> 2][j & 3] + bias[j];
                        const float sg = __builtin_amdgcn_rcpf(1.f + __builtin_amdgcn_exp2f(-1.4426950408889634f * t));
                        v[j] = kind == 0 ? -0.6065306597126334f * sg : (kind == 1 ? sg : t);
                    }
                    u32x4 w; w.x = cvt_pk_bf16(v[0], v[1]); w.y = cvt_pk_bf16(v[2], v[3]); w.z = cvt_pk_bf16(v[4], v[5]); w.w = cvt_pk_bf16(v[6], v[7]);
                    *(u32x4*)(O + (size_t)row * ldc + c) = w;
                }
        }
    }
};
struct EpiSwiGLU {
    static constexpr bool PERM = true, AFTER_DRAIN = false;
    bf16_t* O; int ldc; const ssq_t* ss; float inv_k;
    __device__ __forceinline__ void operator()(const f32x4 (&acc)[2][2][4][2], const Unit& u, int wr, int wc, int fr, int fq) const {
        const int row0 = u.pm * BM + wr * 64 + fr, col0 = u.pn * HALF + wc * 32 + 8 * fq;
#pragma unroll
        for (int ai = 0; ai < 2; ++ai)
#pragma unroll
            for (int m = 0; m < 4; ++m) {
                const int row = row0 + ai * HALF + m * 16;
                const float rs = ssq_rs(ss + row, inv_k);
                float hv[8];
#pragma unroll
                for (int j = 0; j < 8; ++j) {
                    const float gt = acc[ai][0][m][j >> 2][j & 3] * rs, up = acc[ai][1][m][j >> 2][j & 3] * rs;
                    hv[j] = gt * __builtin_amdgcn_rcpf(1.f + __builtin_amdgcn_exp2f(-1.4426950408889634f * gt)) * up;
                }
                u32x4 w; w.x = cvt_pk_bf16(hv[0], hv[1]); w.y = cvt_pk_bf16(hv[2], hv[3]); w.z = cvt_pk_bf16(hv[4], hv[5]); w.w = cvt_pk_bf16(hv[6], hv[7]);
                *(u32x4*)(O + (size_t)row * ldc + col0) = w;
            }
    }
};
struct EpiResid {
    static constexpr bool PERM = false, AFTER_DRAIN = false;
    const float* base; float* out; bf16_t* xb; ssq_t* sq; int ldc; float scale;
    __device__ __forceinline__ void operator()(const f32x4 (&acc)[2][2][4][2], const Unit& u, int wr, int wc, int fr, int fq) const {
        const int row0 = u.pm * BM + wr * 64 + fr, col0 = u.pn * BM + wc * 32 + 4 * fq;
        f32x4 bv[4][4];
#define ER_LOAD(gi) do { const size_t off_ = (size_t)(row0 + ((gi) >> 2) * HALF + ((gi) & 3) * 16) * ldc + col0; \
        _Pragma("unroll") for (int q_ = 0; q_ < 4; ++q_) bv[(gi) & 3][q_] = *(const f32x4*)(base + off_ + (q_ >> 1) * HALF + (q_ & 1) * 16); } while (0)
        ER_LOAD(0); ER_LOAD(1); ER_LOAD(2);
#pragma unroll
        for (int gi = 0; gi < 8; ++gi) {
            if (gi + 3 < 8) ER_LOAD(gi + 3);
            const int ai = gi >> 2, m = gi & 3;
            const size_t off = (size_t)(row0 + ai * HALF + m * 16) * ldc + col0;
            float q = 0.f;
#pragma unroll
            for (int qq = 0; qq < 4; ++qq) {
                const int bj = qq >> 1, n = qq & 1;
                const size_t o2 = off + bj * HALF + n * 16;
                const f32x4 o = bv[gi & 3][qq] + acc[ai][bj][m][n] * scale;
                *(f32x4*)(out + o2) = o;
                if (xb) { u32x2 w; w.x = cvt_pk_bf16(o[0], o[1]); w.y = cvt_pk_bf16(o[2], o[3]); *(u32x2*)(xb + o2) = w; }
                q += (o[0] * o[0] + o[1] * o[1]) + (o[2] * o[2] + o[3] * o[3]);
            }
            if (xb) { q += __shfl_xor(q, 16); q += __shfl_xor(q, 32); if (fq == 0) ssq_add(sq + row0 + ai * HALF + m * 16, q); }
        }
#undef ER_LOAD
    }
};

struct EpiAny {
    static constexpr bool AFTER_DRAIN = false;
    int kind; bool perm; bf16_t* O; int ldc; const void* ss; float inv_k; void* p0; void* p1;
    __device__ __forceinline__ void operator()(const f32x4 (&acc)[2][2][4][2], const Unit& u, int wr, int wc, int fr, int fq) const {
        if (kind == 1) { EpiStore e{O, ldc, (const ssq_t*)ss, inv_k, (ssq_t*)p0, (ssq_t*)p1}; e(acc, u, wr, wc, fr, fq); }
        else if (kind == 2) { EpiSwiGLU e{O, ldc, (const ssq_t*)ss, inv_k}; e(acc, u, wr, wc, fr, fq); }
        else if (kind == 3) { EpiResid e{(const float*)ss, (float*)p0, O, (ssq_t*)p1, ldc, inv_k}; e(acc, u, wr, wc, fr, fq); }
        else { EpiLora e{O, ldc, (const float*)p0, (const float*)p1}; e(acc, u, wr, wc, fr, fq); }
    }
};
template <class Epi, class Sched, bool ALIGN_EPI = false, bool SP2 = false>
__device__ __forceinline__ void gemm_phase(PG8_LAS unsigned char* lds, const Gemm g, const Sched& S, const Epi& E, const int tid_in) {
    const int tid = tid_in, wid = __builtin_amdgcn_readfirstlane(tid >> 6), lane = tid & 63, wr = wid >> 2, wc = wid & 3, fr = lane & 15, fq = lane >> 4;
    const int K = g.K, nt = K / BK;
    unsigned voffA[2], voffB[2];
#pragma unroll
    for (int i = 0; i < 2; ++i) { int R, C; stage_rc(tid * 16 + i * 8192, R, C); const int Rb = E.perm ? ((R & ~31) + perm32(R & 31)) : R;
        voffA[i] = (unsigned)(R * g.lda + C) * 2u; voffB[i] = (unsigned)(Rb * K + C) * 2u; }
    const size_t kstep = (size_t)(BK * 2);
    const size_t hstep = (size_t)HALF * K * 2;
    const size_t tstep = 2 * hstep; const size_t hstepA = (size_t)HALF * g.lda * 2, tstepA = 2 * hstepA;
    const unsigned ldsw = (unsigned)wid * 1024u;
    const int aoff = lds_byte(wr * 64 + fr, fq * 8), boff = lds_byte(wc * 32 + fr, fq * 8);
#define PG8_SA(b, h) (((b) * 2 + (h)) * HTB)
#define PG8_SB(b, h) ((4 + (b) * 2 + (h)) * HTB)
#define PG8_STAGE(bufoff, gbase, voff) do { _Pragma("unroll") for (int _i = 0; _i < 2; ++_i) \
        __builtin_amdgcn_global_load_lds((const unsigned*)((const char*)(gbase) + (voff)[_i]), (PG8_LAS unsigned*)(lds + (bufoff) + ldsw + _i * 8192), 16, 0, 0); } while (0)
#define PG8_LDA(dst, b, h) do { _Pragma("unroll") for (int m = 0; m < 4; ++m) _Pragma("unroll") for (int k = 0; k < 2; ++k) dst[m][k] = *(const PG8_LAS bf16x8*)(lds + PG8_SA(b, h) + aoff + m * 2048 + k * 1024); } while (0)
#define PG8_LDB(dst, b, h) do { _Pragma("unroll") for (int n = 0; n < 2; ++n) _Pragma("unroll") for (int k = 0; k < 2; ++k) dst[n][k] = *(const PG8_LAS bf16x8*)(lds + PG8_SB(b, h) + boff + n * 2048 + k * 1024); } while (0)
#define PG8_MMA(ai, bj, At, Bt) do { __builtin_amdgcn_s_setprio(1); _Pragma("unroll") for (int m = 0; m < 4; ++m) _Pragma("unroll") for (int n = 0; n < 2; ++n) _Pragma("unroll") for (int k = 0; k < 2; ++k) \
        acc[ai][bj][m][n] = __builtin_amdgcn_mfma_f32_16x16x32_bf16(Bt[n][k], At[m][k], acc[ai][bj][m][n], 0, 0, 0); __builtin_amdgcn_s_setprio(0); } while (0)
#define PG8_WAIT_V(n) asm volatile("s_waitcnt vmcnt(" #n ")" ::: "memory")
#define PG8_WAIT_L(n) asm volatile("s_waitcnt lgkmcnt(" #n ")" ::: "memory")
#define PG8_BAR __builtin_amdgcn_s_barrier()
#define PG8_SCHED __builtin_amdgcn_sched_barrier(0)
    Unit cur, nxt; int ui = 0;
    if (!S.next(0, cur)) return;
    f32x4 acc[2][2][4][2];
#pragma unroll
    for (int a = 0; a < 2; ++a)
#pragma unroll
        for (int b = 0; b < 2; ++b)
#pragma unroll
            for (int m = 0; m < 4; ++m)
#pragma unroll
                for (int n = 0; n < 2; ++n) acc[a][b][m][n] = (f32x4){0.f, 0.f, 0.f, 0.f};
    bf16x8 At[4][2], B0[2][2], B1[2][2];
    const char* cA = (const char*)g.A + (size_t)cur.pm * tstepA; const char* cB = (const char*)g.Bt + (size_t)cur.pn * tstep;
    S.a_ready(cur);
    if constexpr (SP2) {
        PG8_STAGE(PG8_SB(0, 0), cB, voffB); PG8_STAGE(PG8_SB(0, 1), cB + hstep, voffB); PG8_STAGE(PG8_SA(0, 0), cA, voffA); PG8_STAGE(PG8_SA(0, 1), cA + hstepA, voffA);
        if (wr == 1) PG8_BAR;
        PG8_WAIT_V(2); PG8_BAR;
        PG8_STAGE(PG8_SB(1, 0), cB + kstep, voffB); PG8_STAGE(PG8_SA(1, 0), cA + kstep, voffA); PG8_STAGE(PG8_SB(1, 1), cB + hstep + kstep, voffB);
        PG8_WAIT_V(6); PG8_BAR;
    } else {
        PG8_STAGE(PG8_SB(0, 0), cB, voffB); PG8_STAGE(PG8_SA(0, 0), cA, voffA); PG8_STAGE(PG8_SB(0, 1), cB + hstep, voffB); PG8_STAGE(PG8_SA(0, 1), cA + hstepA, voffA);
        if (wr == 1) PG8_BAR;
        PG8_WAIT_V(4); PG8_BAR;
        PG8_STAGE(PG8_SB(1, 0), cB + kstep, voffB); PG8_STAGE(PG8_SA(1, 0), cA + kstep, voffA); PG8_STAGE(PG8_SB(1, 1), cB + hstep + kstep, voffB);
        PG8_WAIT_V(6); PG8_BAR;
    }
    for (;;) {
        const bool has_next = S.next(ui + 1, nxt);
        const char* nA = has_next ? (const char*)g.A + (size_t)nxt.pm * tstepA : cA; const char* nB = has_next ? (const char*)g.Bt + (size_t)nxt.pn * tstep : cB;
        for (int t = 0; t < nt; t += 2) {
            const bool last = (t == nt - 2);
            const char* a1 = cA + (size_t)(t + 1) * kstep;
            const char* a2 = last ? nA : cA + (size_t)(t + 2) * kstep; const char* b2 = last ? nB : cB + (size_t)(t + 2) * kstep;
            const char* a3 = a2 + kstep; const char* b3 = b2 + kstep;
            if (last && has_next) S.a_ready(nxt);
            if constexpr (SP2) {
            PG8_LDB(B0, 0, 0); PG8_LDB(B1, 0, 1); PG8_SCHED; PG8_LDA(At, 0, 0); PG8_STAGE(PG8_SA(1, 1), a1 + hstepA, voffA);
            PG8_WAIT_V(8); PG8_WAIT_L(0); PG8_BAR; PG8_MMA(0, 0, At, B0); PG8_MMA(0, 1, At, B1); PG8_BAR; PG8_SCHED;
            PG8_LDA(At, 0, 1); PG8_STAGE(PG8_SB(0, 0), b2, voffB); PG8_STAGE(PG8_SB(0, 1), b2 + hstep, voffB); PG8_STAGE(PG8_SA(0, 0), a2, voffA);
            PG8_WAIT_V(8); PG8_WAIT_L(0); PG8_BAR; PG8_MMA(1, 0, At, B0); PG8_MMA(1, 1, At, B1); PG8_BAR; PG8_SCHED;
            PG8_LDB(B0, 1, 0); PG8_LDB(B1, 1, 1); PG8_SCHED; PG8_LDA(At, 1, 0); PG8_STAGE(PG8_SA(0, 1), a2 + hstepA, voffA);
            PG8_WAIT_V(8); PG8_WAIT_L(0); PG8_BAR; PG8_MMA(0, 0, At, B0); PG8_MMA(0, 1, At, B1); PG8_BAR; PG8_SCHED;
            PG8_LDA(At, 1, 1); PG8_STAGE(PG8_SB(1, 0), b3, voffB); PG8_STAGE(PG8_SB(1, 1), b3 + hstep, voffB); PG8_STAGE(PG8_SA(1, 0), a3, voffA);
            PG8_WAIT_V(8); PG8_WAIT_L(0); PG8_BAR; PG8_MMA(1, 0, At, B0); PG8_MMA(1, 1, At, B1); PG8_BAR; PG8_SCHED;
            } else {
            PG8_LDB(B0, 0, 0); PG8_SCHED; PG8_LDA(At, 0, 0); PG8_STAGE(PG8_SA(1, 1), a1 + hstepA, voffA);
            PG8_WAIT_L(8); PG8_BAR; PG8_WAIT_L(0); PG8_MMA(0, 0, At, B0); PG8_BAR; PG8_SCHED;
            PG8_LDB(B1, 0, 1); PG8_STAGE(PG8_SB(0, 0), b2, voffB);
            PG8_BAR; PG8_WAIT_L(0); PG8_MMA(0, 1, At, B1); PG8_BAR;
            PG8_LDA(At, 0, 1); PG8_STAGE(PG8_SA(0, 0), a2, voffA);
            PG8_BAR; PG8_WAIT_L(0); PG8_MMA(1, 0, At, B0); PG8_BAR; PG8_SCHED;
            PG8_STAGE(PG8_SB(0, 1), b2 + hstep, voffB);
            PG8_WAIT_V(6); PG8_BAR; PG8_MMA(1, 1, At, B1); PG8_BAR;
            PG8_LDB(B0, 1, 0); PG8_SCHED; PG8_LDA(At, 1, 0); PG8_STAGE(PG8_SA(0, 1), a2 + hstepA, voffA);
            PG8_WAIT_L(8); PG8_BAR; PG8_WAIT_L(0); PG8_MMA(0, 0, At, B0); PG8_BAR; PG8_SCHED;
            PG8_LDB(B1, 1, 1); PG8_STAGE(PG8_SB(1, 0), b3, voffB);
            PG8_BAR; PG8_WAIT_L(0); PG8_MMA(0, 1, At, B1); PG8_BAR;
            PG8_LDA(At, 1, 1); PG8_STAGE(PG8_SA(1, 0), a3, voffA);
            PG8_BAR; PG8_WAIT_L(0); PG8_MMA(1, 0, At, B0); PG8_BAR; PG8_SCHED;
            PG8_STAGE(PG8_SB(1, 1), b3 + hstep, voffB);
            PG8_WAIT_V(6); PG8_BAR; PG8_MMA(1, 1, At, B1); PG8_BAR;
            }
        }
        if constexpr (ALIGN_EPI) { if (wr == 0) PG8_BAR; }
        if constexpr (!Epi::AFTER_DRAIN) { E(acc, cur, wr, wc, fr, fq); S.done(cur); }
        if (!has_next) break;
#pragma unroll
        for (int a = 0; a < 2; ++a)
#pragma unroll
            for (int b = 0; b < 2; ++b)
#pragma unroll
                for (int m = 0; m < 4; ++m)
#pragma unroll
                    for (int n = 0; n < 2; ++n) acc[a][b][m][n] = (f32x4){0.f, 0.f, 0.f, 0.f};
        cur = nxt; cA = nA; cB = nB; ++ui;
        if constexpr (ALIGN_EPI) { if (wr == 1) PG8_BAR; }
    }
    PG8_WAIT_V(0);
    if constexpr (!ALIGN_EPI) { if (wr == 0) PG8_BAR; }
    PG8_BAR;
    if constexpr (Epi::AFTER_DRAIN) { E.fused(acc, cur, wr, wc, fr, fq, lds, wid, lane); S.done(cur); }
#undef PG8_SA
#undef PG8_SB
#undef PG8_STAGE
#undef PG8_LDA
#undef PG8_LDB
#undef PG8_MMA
#undef PG8_WAIT_V
#undef PG8_WAIT_L
#undef PG8_BAR
#undef PG8_SCHED
}
}

#define LAS __attribute__((address_space(3)))
using pg8::bf16_t; using pg8::bf16x8; using pg8::f32x4; using pg8::u32x4; using pg8::u32x2; using pg8::f32x2; using pg8::cvt_pk_bf16; using pg8::ssq_t;
typedef float f32x16 __attribute__((ext_vector_type(16)));
typedef short s16x4 __attribute__((ext_vector_type(4)));
typedef short v4i16_t __attribute__((ext_vector_type(4)));

constexpr int NB = 8, SEQ = 2048, DM = 2048, MT = NB * SEQ, FF = 5632, MEML = 256;
constexpr int ABN = 4896, ABP = 5120, CDN = 3872, CDP = 4096;
constexpr float EPS = 1e-6f, LOG2E = 1.4426950408889634f;
constexpr float LAMBDA_INIT = 0.3555090675f;
constexpr int NPHASE = 26;
constexpr int NTHREADS = 512;
constexpr int LDS_BYTES = 147456;

constexpr size_t MiB = (size_t)1 << 20;
constexpr size_t WS_SS = 656 * MiB, WS_CS64 = 1 * MiB, WS_CS32 = 5 * MiB, WS_MEMB = 7 * MiB, WS_MEMKV = 15 * MiB, WS_MEMVT = 19 * MiB;
constexpr size_t WS_WGUA = 21 * MiB, WS_WDA = 65 * MiB, WS_WGUB = 87 * MiB, WS_WDB = 131 * MiB;
constexpr size_t WS_WABIN = 153 * MiB, WS_WABOUT = 173 * MiB, WS_WCDIN = 181 * MiB, WS_WCDOUT = 197 * MiB, WS_WUQ = 205 * MiB, WS_WUKV = 207 * MiB;
constexpr size_t WS_WMQ = 208 * MiB, WS_WMO = 212 * MiB, WS_WMKV = 216 * MiB, WS_WLORA = 220 * MiB;
constexpr size_t WS_XB = 224 * MiB, WS_BIG = 288 * MiB, WS_BAR = 658 * MiB, WS_WGUC = 659 * MiB, WS_WDC = 703 * MiB, WS_END = 725 * MiB;
constexpr size_t B_H = 0;
constexpr size_t B0_U = 0, B0_LIN = 160 * MiB, B0_LOUT = 176 * MiB, B0_VT = 272 * MiB, B0_Y = 280 * MiB;
constexpr size_t B1_U = 0, B1_Q = 128 * MiB, B1_KV = 176 * MiB, B1_VTM = 240 * MiB, B1_VTD = 272 * MiB, B1_Y = 304 * MiB;
constexpr size_t BM_Q = 0, BM_O = 16 * MiB;
enum { SS_A0 = 0, SS_B0, SS_C0, SS_D0, SS_A1, SS_B1, SS_C1, SS_D1, SS_CQ, SS_CKV, SS_MEM, SS_DUMMY, SS_N };

enum { I_X = 0, I_MEM, I_POS, I_F1N, I_F1G, I_F1U, I_F1D, I_MIXN, I_ABIN, I_ABOUT, I_SWAQN, I_SWAKN, I_SINKS, I_MU, I_W0, I_W2, I_A0, I_A2, I_G2, I_KK, I_KA, I_RK, I_GNG, I_GNB,
       I_CDIN, I_CDOUT, I_CQN, I_CKVN, I_WUQ, I_WUKV, I_QNOPEN, I_KNOPEN, I_QROPEN, I_KROPEN, I_DQN, I_DKN, I_LQ1, I_LK1, I_LQ2, I_LK2, I_SUBLN, I_MXN, I_MXWQ, I_MXQN, I_MXWO,
       I_MEMN, I_MEMWKV, I_MEMKN, I_F2N, I_F2G, I_F2U, I_F2D, N_IN };

struct Params { const float* in[N_IN]; float* out; unsigned char* ws; int ph_lo, ph_hi; };

__device__ __forceinline__ float bf2f(bf16_t v) { return __uint_as_float((unsigned)v << 16); }
__device__ __forceinline__ bf16_t f2bf(float f) { return (bf16_t)(cvt_pk_bf16(f, 0.f) & 0xffffu); }
__device__ __forceinline__ float wave_sum(float v) {
#pragma unroll
    for (int o = 1; o < 64; o <<= 1) v += __shfl_xor(v, o);
    return v;
}
__device__ __forceinline__ float fexp2(float x) { return __builtin_amdgcn_exp2f(x); }

__device__ __forceinline__ void conv_matrix(const float* W, int K, int N, const float* gain, bf16_t* WT, int Kd, int mode, int row_off, LAS float* scr, int lane, int gw, int NGW) {
    const int nblk = N / 32, items = nblk * (K / 64);
    for (int it = gw; it < items; it += NGW) {
        const int kb = it / nblk, nb = it % nblk, k0 = 64 * kb, n0 = 32 * nb;
        float wv[32];
#pragma unroll
        for (int i = 0; i < 32; ++i) wv[i] = W[(size_t)(k0 + 2 * i + (lane >> 5)) * N + n0 + (lane & 31)];
        if (gain) {
#pragma unroll
            for (int i = 0; i < 32; ++i) wv[i] *= gain[k0 + 2 * i + (lane >> 5)];
        }
#pragma unroll
        for (int i = 0; i < 32; ++i) scr[(2 * i + (lane >> 5)) * 33 + (lane & 31)] = wv[i];
        asm volatile("s_waitcnt lgkmcnt(0)" ::: "memory");
        const int c = lane & 7;
        const int rbase = mode == 0 ? row_off + n0 : ((n0 >> 7) * 256 + (n0 & 127) + (mode == 2 ? 128 : 0));
#pragma unroll
        for (int j = 0; j < 4; ++j) { const int n = (lane >> 3) + 8 * j; const LAS float* s = scr + (8 * c) * 33 + n;
            u32x4 o; o.x = cvt_pk_bf16(s[0 * 33], s[1 * 33]); o.y = cvt_pk_bf16(s[2 * 33], s[3 * 33]); o.z = cvt_pk_bf16(s[4 * 33], s[5 * 33]); o.w = cvt_pk_bf16(s[6 * 33], s[7 * 33]);
            *(u32x4*)(WT + (size_t)(rbase + n) * Kd + k0 + 8 * c) = o; }
        asm volatile("s_waitcnt lgkmcnt(0)" ::: "memory");
    }
}
__device__ __forceinline__ void conv_ffn(const LAS Params* PL, int L, int which  , LAS float* scr, int lane, int gw, int NGW) {
    const float* nrm = PL->in[which ? I_F2N : I_F1N] + (size_t)L * DM;
    const float* wg = PL->in[which ? I_F2G : I_F1G] + (size_t)L * DM * FF;
    const float* wu = PL->in[which ? I_F2U : I_F1U] + (size_t)L * DM * FF;
    const float* wd = PL->in[which ? I_F2D : I_F1D] + (size_t)L * FF * DM;
    bf16_t* gu = (bf16_t*)(PL->ws + (which ? (L ? WS_WGUC : WS_WGUB) : WS_WGUA)); bf16_t* dn = (bf16_t*)(PL->ws + (which ? (L ? WS_WDC : WS_WDB) : WS_WDA));
    conv_matrix(wg, DM, FF, nrm, gu, DM, 1, 0, scr, lane, gw, NGW);
    conv_matrix(wu, DM, FF, nrm, gu, DM, 2, 0, scr, lane, gw, NGW);
    conv_matrix(wd, FF, DM, nullptr, dn, FF, 0, 0, scr, lane, gw, NGW);
}
__device__ __forceinline__ void row_to_bf16(const float* xrow, bf16_t* orow, ssq_t* ssq, int lane) {
    const f32x4* xr = (const f32x4*)xrow + lane; float s = 0.f; f32x4 v[8];
#pragma unroll
    for (int j = 0; j < 8; ++j) { v[j] = xr[64 * j]; s += (v[j][0] * v[j][0] + v[j][1] * v[j][1]) + (v[j][2] * v[j][2] + v[j][3] * v[j][3]); }
    s = wave_sum(s);
    u32x2* o8 = (u32x2*)orow + lane;
#pragma unroll
    for (int j = 0; j < 8; ++j) { u32x2 w; w.x = cvt_pk_bf16(v[j][0], v[j][1]); w.y = cvt_pk_bf16(v[j][2], v[j][3]); o8[64 * j] = w; }
    if (lane == 0) *ssq = (ssq_t)(s * pg8::SSQ_SCALE + 0.5f);
}
__device__ __forceinline__ void vt_transpose(const bf16_t* src, int pitch, int col0, int hstride, int nh, int DVh, int Sk, bf16_t* dst, int lane, int gw, int NGW) {
    const int sblk = Sk / 64, items = NB * nh * sblk;
    for (int it = gw; it < items; it += NGW) {
        const int sb = it % sblk, hd = (it / sblk) % nh, b = it / (sblk * nh);
        const int s = sb * 64 + lane;
        const bf16_t* sp = src + (size_t)(b * Sk + s) * pitch + col0 + hd * hstride;
        bf16_t* dp = dst + (size_t)((b * nh + hd) * DVh) * Sk + s;
        for (int dc = 0; dc < DVh / 8; ++dc) {
            const bf16x8 v = *(const bf16x8*)(sp + dc * 8);
#pragma unroll
            for (int j = 0; j < 8; ++j) dp[(size_t)(dc * 8 + j) * Sk] = (bf16_t)v[j];
        }
    }
}
template <int N>
__device__ __forceinline__ void norm_rope_row(bf16_t* p, int hstride, int nheads, const float* g, const f32x2* cs, int lane) {
    constexpr int GL = N / 8, HPP = 64 / GL, HALFN = N / 2;
    const int j = lane % GL, hl = lane / GL;
    const f32x4 g0 = *(const f32x4*)(g + 4 * j), g1 = *(const f32x4*)(g + HALFN + 4 * j);
    f32x4 c01 = {1.f, 0.f, 1.f, 0.f}, c23 = {1.f, 0.f, 1.f, 0.f};
    if (cs) { c01 = *(const f32x4*)(cs + 4 * j); c23 = *(const f32x4*)(cs + 4 * j + 2); }
    for (int h0 = 0; h0 < nheads; h0 += HPP) {
        const int hd = h0 + hl; const bool act = hd < nheads;
        bf16_t* q = p + (size_t)hd * hstride + 4 * j;
        u32x2 w0 = {0u, 0u}, w1 = {0u, 0u};
        if (act) { w0 = *(const u32x2*)q; w1 = *(const u32x2*)(q + HALFN); }
        float x0[4] = {__uint_as_float(w0.x << 16), __uint_as_float(w0.x & 0xffff0000u), __uint_as_float(w0.y << 16), __uint_as_float(w0.y & 0xffff0000u)};
        float x1[4] = {__uint_as_float(w1.x << 16), __uint_as_float(w1.x & 0xffff0000u), __uint_as_float(w1.y << 16), __uint_as_float(w1.y & 0xffff0000u)};
        float ss = (x0[0] * x0[0] + x0[1] * x0[1]) + (x0[2] * x0[2] + x0[3] * x0[3]) + (x1[0] * x1[0] + x1[1] * x1[1]) + (x1[2] * x1[2] + x1[3] * x1[3]);
#pragma unroll
        for (int o = 1; o < GL; o <<= 1) ss += __shfl_xor(ss, o);
        const float rs = __builtin_amdgcn_rsqf(ss * (1.f / N) + EPS);
        float y0[4], y1[4];
#pragma unroll
        for (int e = 0; e < 4; ++e) {
            const float a = x0[e] * rs * g0[e], b = x1[e] * rs * g1[e];
            const float co = e < 2 ? c01[2 * e] : c23[2 * (e - 2)], si = e < 2 ? c01[2 * e + 1] : c23[2 * (e - 2) + 1];
            y0[e] = a * co - b * si; y1[e] = a * si + b * co;
        }
        if (act) { u32x2 o0, o1; o0.x = cvt_pk_bf16(y0[0], y0[1]); o0.y = cvt_pk_bf16(y0[2], y0[3]); o1.x = cvt_pk_bf16(y1[0], y1[1]); o1.y = cvt_pk_bf16(y1[2], y1[3]);
            *(u32x2*)q = o0; *(u32x2*)(q + HALFN) = o1; }
    }
}

struct AttSrc { const bf16_t* q; int qp; const bf16_t* ka; int kap; const bf16_t* kb; int kbp; const bf16_t* v; int vp; int SK; const f32x2* qcs; const float* qg2; };
__device__ __forceinline__ int crow(int r, int hi) { return (r & 3) + 8 * (r >> 2) + 4 * hi; }
#define MFMA32(a, b, c) __builtin_amdgcn_mfma_f32_32x32x16_bf16((a), (b), (c), 0, 0, 0)

template <int DK, int DV, int MODE>
__device__ __forceinline__ void attn_tile(const LAS unsigned char* Kl, const LAS unsigned char* Vl, const bf16x8 (&qf)[DK / 16], f32x16 (&o)[DV / 32], float& m, float& l,
                                          int t, int q0, int wid, int r, int h, int qrow, float c) {
    constexpr int KS = DK / 16, KSTR = DK * 2 + 16, VSTR = DV * 2 + 16;
        const int k0 = t * 64;
        if (MODE != 2) { const int qlo = q0 + wid * 32; if (k0 > qlo + 31 || (MODE == 1 && qlo - (k0 + 63) >= 128)) return; }
        f32x16 p0, p1;
#pragma unroll
        for (int i = 0; i < 16; ++i) { p0[i] = 0.f; p1[i] = 0.f; }
#pragma unroll
        for (int ks = 0; ks < KS; ++ks) {
            const bf16x8 a0 = *(const LAS bf16x8*)(Kl + r * KSTR + (16 * ks + 8 * h) * 2);
            const bf16x8 a1 = *(const LAS bf16x8*)(Kl + (r + 32) * KSTR + (16 * ks + 8 * h) * 2);
            p0 = MFMA32(a0, qf[ks], p0); p1 = MFMA32(a1, qf[ks], p1);
        }
        bool need_mask = false;
        if (MODE == 0) need_mask = (k0 + 63 > q0 + wid * 32);
        if (MODE == 1) need_mask = (k0 + 63 > q0 + wid * 32) || (q0 + wid * 32 + 31 - k0 >= 128);
        float mx = -INFINITY;
#pragma unroll
        for (int i = 0; i < 16; ++i) {
            float s0 = p0[i] * c, s1 = p1[i] * c;
            if (need_mask) {
                const int key0 = k0 + crow(i, h), key1 = key0 + 32;
                const bool v0 = (key0 <= qrow) && (MODE != 1 || qrow - key0 < 128);
                const bool v1 = (key1 <= qrow) && (MODE != 1 || qrow - key1 < 128);
                s0 = v0 ? s0 : -INFINITY; s1 = v1 ? s1 : -INFINITY;
            }
            p0[i] = s0; p1[i] = s1; mx = fmaxf(mx, fmaxf(s0, s1));
        }
        mx = fmaxf(mx, __shfl_xor(mx, 32));
        const float m_new = fmaxf(m, mx), m_use = (m_new == -INFINITY) ? 0.f : m_new;
        const float alpha = fexp2(m - m_use);
        float ls = 0.f;
#pragma unroll
        for (int i = 0; i < 16; ++i) { p0[i] = fexp2(p0[i] - m_use); p1[i] = fexp2(p1[i] - m_use); ls += p0[i] + p1[i]; }
        l = l * alpha + ls; m = m_new;
#pragma unroll
        for (int d = 0; d < DV / 32; ++d)
#pragma unroll
            for (int i = 0; i < 16; ++i) o[d][i] *= alpha;
        bf16x8 pb[4];
#pragma unroll
        for (int sx = 0; sx < 2; ++sx) {
            u32x4 w0, w1;
            w0.x = cvt_pk_bf16(p0[8 * sx + 0], p0[8 * sx + 1]); w0.y = cvt_pk_bf16(p0[8 * sx + 2], p0[8 * sx + 3]); w0.z = cvt_pk_bf16(p0[8 * sx + 4], p0[8 * sx + 5]); w0.w = cvt_pk_bf16(p0[8 * sx + 6], p0[8 * sx + 7]);
            w1.x = cvt_pk_bf16(p1[8 * sx + 0], p1[8 * sx + 1]); w1.y = cvt_pk_bf16(p1[8 * sx + 2], p1[8 * sx + 3]); w1.z = cvt_pk_bf16(p1[8 * sx + 4], p1[8 * sx + 5]); w1.w = cvt_pk_bf16(p1[8 * sx + 6], p1[8 * sx + 7]);
            pb[sx] = __builtin_bit_cast(bf16x8, w0); pb[2 + sx] = __builtin_bit_cast(bf16x8, w1);
        }
#pragma unroll
        for (int d = 0; d < DV / 32; ++d)
#pragma unroll
            for (int t4 = 0; t4 < 4; ++t4) {
                const LAS unsigned char* vp_ = Vl + (16 * t4 + 4 * h + ((r & 15) >> 2)) * VSTR + (32 * d + 16 * (r >> 4) + 4 * (r & 3)) * 2;
                const s16x4 lo = __builtin_bit_cast(s16x4, __builtin_amdgcn_ds_read_tr16_b64_v4i16((LAS v4i16_t*)vp_));
                const s16x4 hi = __builtin_bit_cast(s16x4, __builtin_amdgcn_ds_read_tr16_b64_v4i16((LAS v4i16_t*)(vp_ + 8 * VSTR)));
                const bf16x8 vf = __builtin_shufflevector(lo, hi, 0, 1, 2, 3, 4, 5, 6, 7);
                o[d] = MFMA32(vf, pb[t4], o[d]);
                if (DV > 64 && t4 == 3) __builtin_amdgcn_sched_barrier(0);
            }
}
template <int DKA, int DKB, int DV, int MODE  >
__device__ __forceinline__ void attn_unit(LAS unsigned char* lds, const AttSrc& s, int q0, float c, float sink_l2, const float* qg, f32x16 (&o)[DV / 32], const int tid) {
    constexpr int DK = DKA + DKB, KS = DK / 16, KSTR = DK * 2 + 16, VSTR = DV * 2 + 16, VCH = DV / 8, KBYTES = 64 * KSTR, VBYTES = 64 * VSTR, TB = KBYTES + VBYTES;
    constexpr int KCH = DK / 8, NKC = 64 * KCH, NKR = (NKC + NTHREADS - 1) / NTHREADS, NVR = DV * 8 / NTHREADS;
    const int lane = tid & 63, wid = tid >> 6, r = lane & 31, h = lane >> 5;
    const int qrow = q0 + wid * 32 + r;
    bf16x8 qf[KS];
#pragma unroll
    for (int ks = 0; ks < KS; ++ks) qf[ks] = *(const bf16x8*)(s.q + (size_t)qrow * s.qp + 16 * ks + 8 * h);
    if (MODE == 2) {
        float ssq = 0.f;
#pragma unroll
        for (int ks = 0; ks < KS; ++ks)
#pragma unroll
            for (int j = 0; j < 8; ++j) { const float f = bf2f((bf16_t)qf[ks][j]); ssq += f * f; }
        ssq += __shfl_xor(ssq, 32);
        const float rs = __builtin_amdgcn_rsqf(ssq / (float)DK + EPS);
#pragma unroll
        for (int ks = 0; ks < KS; ++ks)
#pragma unroll
            for (int j = 0; j < 8; ++j) qf[ks][j] = (short)f2bf(bf2f((bf16_t)qf[ks][j]) * rs * qg[16 * ks + 8 * h + j]);
    }
    if (MODE == 1 || (MODE == 0 && DKB == 0)) {
        float xq[4][8]; float ssq = 0.f;
#pragma unroll
        for (int ks = 0; ks < 4; ++ks)
#pragma unroll
            for (int j = 0; j < 8; ++j) { xq[ks][j] = bf2f((bf16_t)qf[ks][j]); ssq += xq[ks][j] * xq[ks][j]; }
        ssq += __shfl_xor(ssq, 32);
        const float rs = __builtin_amdgcn_rsqf(ssq * (1.f / 64.f) + EPS);
#pragma unroll
        for (int ks = 0; ks < 2; ++ks)
#pragma unroll
            for (int j = 0; j < 8; ++j) { const int cidx = 16 * ks + 8 * h + j;
                const float a = xq[ks][j] * rs * qg[cidx], bq = xq[ks + 2][j] * rs * qg[cidx + 32];
                const f32x2 t = s.qcs[(size_t)qrow * 32 + cidx];
                qf[ks][j] = (short)f2bf(a * t.x - bq * t.y); qf[ks + 2][j] = (short)f2bf(a * t.y + bq * t.x); }
    }
    if (MODE == 0 && DKB == 32) {
        float xn[4][8], xp[2][8]; float s1 = 0.f, s2 = 0.f;
#pragma unroll
        for (int ks = 0; ks < 4; ++ks)
#pragma unroll
            for (int j = 0; j < 8; ++j) { xn[ks][j] = bf2f((bf16_t)qf[ks][j]); s1 += xn[ks][j] * xn[ks][j]; }
#pragma unroll
        for (int ks = 0; ks < 2; ++ks)
#pragma unroll
            for (int j = 0; j < 8; ++j) { xp[ks][j] = bf2f((bf16_t)qf[4 + ks][j]); s2 += xp[ks][j] * xp[ks][j]; }
        s1 += __shfl_xor(s1, 32); s2 += __shfl_xor(s2, 32);
        const float r1 = __builtin_amdgcn_rsqf(s1 * (1.f / 64.f) + EPS), r2 = __builtin_amdgcn_rsqf(s2 * (1.f / 32.f) + EPS);
#pragma unroll
        for (int ks = 0; ks < 4; ++ks)
#pragma unroll
            for (int j = 0; j < 8; ++j) qf[ks][j] = (short)f2bf(xn[ks][j] * r1 * qg[16 * ks + 8 * h + j]);
#pragma unroll
        for (int j = 0; j < 8; ++j) { const int cidx = 8 * h + j;
            const float a = xp[0][j] * r2 * s.qg2[cidx], bq = xp[1][j] * r2 * s.qg2[cidx + 16];
            const f32x2 t = s.qcs[(size_t)qrow * 16 + cidx];
            qf[4][j] = (short)f2bf(a * t.x - bq * t.y); qf[5][j] = (short)f2bf(a * t.y + bq * t.x); }
    }
    const int t_lo = MODE == 1 ? (q0 >= 128 ? q0 / 64 - 2 : 0) : 0;
    const int t_hi = MODE == 2 ? s.SK / 64 : q0 / 64 + 4;
    float m = MODE == 1 ? sink_l2 : -INFINITY;
    float l = (MODE == 1 && h == 0) ? 1.f : 0.f;
#pragma unroll
    for (int d = 0; d < DV / 32; ++d)
#pragma unroll
        for (int i = 0; i < 16; ++i) o[d][i] = 0.f;
    constexpr bool PF2 = !(DV == 128 && MODE == 0);
    u32x4 krA[NKR], vrA[NVR], krB[PF2 ? NKR : 1], vrB[PF2 ? NVR : 1];
#define ATT_LOAD(KR, VR, t) do { const int k0_ = (t) * 64; \
        _Pragma("unroll") for (int i = 0; i < NKR; ++i) { const int cc = tid + NTHREADS * i; if (cc < NKC) { const int row = cc / KCH, ch = cc % KCH; \
            const bf16_t* sp = (ch < DKA / 8) ? s.ka + (size_t)(k0_ + row) * s.kap + ch * 8 : s.kb + (size_t)(k0_ + row) * s.kbp + (ch - DKA / 8) * 8; KR[i] = *(const u32x4*)sp; } } \
        _Pragma("unroll") for (int i = 0; i < NVR; ++i) { const int cc = tid + NTHREADS * i; const int key = cc / VCH, ch = cc % VCH; VR[i] = *(const u32x4*)(s.v + (size_t)(k0_ + key) * s.vp + ch * 8); } } while (0)
#define ATT_STORE(KR, VR, Kl, Vl) do { \
        _Pragma("unroll") for (int i = 0; i < NKR; ++i) { const int cc = tid + NTHREADS * i; if (cc < NKC) { const int row = cc / KCH, ch = cc % KCH; *(LAS u32x4*)((Kl) + row * KSTR + ch * 16) = KR[i]; } } \
        _Pragma("unroll") for (int i = 0; i < NVR; ++i) { const int cc = tid + NTHREADS * i; const int key = cc / VCH, ch = cc % VCH; *(LAS u32x4*)((Vl) + key * VSTR + ch * 16) = VR[i]; } } while (0)
    ATT_LOAD(krA, vrA, t_lo);
    if (PF2) { if (t_lo + 1 < t_hi) ATT_LOAD(krB, vrB, t_lo + 1); }
    constexpr int STEP = PF2 ? 2 : 1;
    for (int t = t_lo; t < t_hi; t += STEP) {
        {
            LAS unsigned char* Kl = lds + (PF2 ? 0 : ((t - t_lo) & 1)) * TB; LAS unsigned char* Vl = Kl + KBYTES;
            ATT_STORE(krA, vrA, Kl, Vl);
            __syncthreads();
            if (t + STEP < t_hi) ATT_LOAD(krA, vrA, t + STEP);
            attn_tile<DK, DV, MODE>(Kl, Vl, qf, o, m, l, t, q0, wid, r, h, qrow, c);
        }
        if (PF2) { if (t + 1 < t_hi) {
            LAS unsigned char* Kl = lds + TB; LAS unsigned char* Vl = Kl + KBYTES;
            ATT_STORE(krB, vrB, Kl, Vl);
            __syncthreads();
            if (t + 3 < t_hi) ATT_LOAD(krB, vrB, t + 3);
            attn_tile<DK, DV, MODE>(Kl, Vl, qf, o, m, l, t + 1, q0, wid, r, h, qrow, c);
        } }
    }
#undef ATT_LOAD
#undef ATT_STORE
    l += __shfl_xor(l, 32);
    const float inv = 1.f / l;
#pragma unroll
    for (int d = 0; d < DV / 32; ++d)
#pragma unroll
        for (int i = 0; i < 16; ++i) o[d][i] *= inv;
    __syncthreads();
}
template <int DV>
__device__ __forceinline__ void attn_store(const f32x16 (&o)[DV / 32], bf16_t* yrow, int h) {
#pragma unroll
    for (int d = 0; d < DV / 32; ++d)
#pragma unroll
        for (int p = 0; p < 2; ++p) {
            const int ie = 2 * p, io = 2 * p + 1;
            const unsigned x0 = cvt_pk_bf16(o[d][4 * ie], o[d][4 * ie + 1]), x1 = cvt_pk_bf16(o[d][4 * ie + 2], o[d][4 * ie + 3]);
            const unsigned y0 = cvt_pk_bf16(o[d][4 * io], o[d][4 * io + 1]), y1 = cvt_pk_bf16(o[d][4 * io + 2], o[d][4 * io + 3]);
            const auto r0 = __builtin_amdgcn_permlane32_swap(x0, y0, false, false);
            const auto r1 = __builtin_amdgcn_permlane32_swap(x1, y1, false, false);
            u32x4 w; w.x = r0[0]; w.y = r1[0]; w.z = r0[1]; w.w = r1[1];
            *(u32x4*)(yrow + 32 * d + 8 * (2 * p + h)) = w;
        }
}

constexpr int TC = 32;
#define DPP_ADD(v, ctrl) ((v) + __int_as_float(__builtin_amdgcn_update_dpp(0, __float_as_int(v), (ctrl), 0xF, 0xF, true)))
__device__ __forceinline__ float red8(float v) { v = DPP_ADD(v, 0xB1); v = DPP_ADD(v, 0x4E); v = DPP_ADD(v, 0x141); return v; }

__device__ __forceinline__ void rwkv_unit(LAS unsigned char* lds, const LAS Params* PL, int b, int h, const int tid) {
    const bf16_t* u = (const bf16_t*)(PL->ws + WS_BIG + B0_U); const bf16_t* lo = (const bf16_t*)(PL->ws + WS_BIG + B0_LOUT); bf16_t* y = (bf16_t*)(PL->ws + WS_BIG + B0_Y);
    LAS float* A = (LAS float*)lds;
    LAS float* Gb = A + 2 * TC * 384;
    LAS float* Yb = Gb + 2 * TC * 64;
    LAS float* BON = Yb + 2 * TC * 64;
    const int lane = tid & 63, wid = tid >> 6;
    constexpr int NC = SEQ / TC;
    if (wid < 4) {
        const int rg = tid >> 3, jg = tid & 7;
        f32x2 S[8];
#pragma unroll
        for (int j = 0; j < 8; ++j) S[j] = (f32x2){0.f, 0.f};
        __syncthreads();
        for (int chn = 0; chn < NC; ++chn) {
            const LAS float* Ab = A + (chn & 1) * TC * 384 + 8 * jg;
            const LAS float* Av = A + (chn & 1) * TC * 384 + 320 + rg;
            LAS float* Yc = Yb + (chn & 1) * TC * 64 + rg;
#define RW_LV(V, tl) do { const LAS float* a_ = Ab + (tl) * 384; V##d0 = *(const LAS f32x4*)(a_); V##d1 = *(const LAS f32x4*)(a_ + 4); V##n0 = *(const LAS f32x4*)(a_ + 64); V##n1 = *(const LAS f32x4*)(a_ + 68); \
                V##e0 = *(const LAS f32x4*)(a_ + 128); V##e1 = *(const LAS f32x4*)(a_ + 132); V##k0 = *(const LAS f32x4*)(a_ + 192); V##k1 = *(const LAS f32x4*)(a_ + 196); \
                V##r0 = *(const LAS f32x4*)(a_ + 256); V##r1 = *(const LAS f32x4*)(a_ + 260); V##va = Av[(tl) * 384]; V##vb = Av[(tl) * 384 + 32]; } while (0)
#define RW_ROW2(V, yo) do { \
                f32x2 accA = S[0] * (f32x2){V##n0[0], V##n0[1]}, accB = S[4] * (f32x2){V##n0[0], V##n0[1]}; \
                f32x2 acc2A = S[2] * (f32x2){V##n1[0], V##n1[1]}, acc2B = S[6] * (f32x2){V##n1[0], V##n1[1]}; \
                accA = S[1] * (f32x2){V##n0[2], V##n0[3]} + accA; accB = S[5] * (f32x2){V##n0[2], V##n0[3]} + accB; \
                acc2A = S[3] * (f32x2){V##n1[2], V##n1[3]} + acc2A; acc2B = S[7] * (f32x2){V##n1[2], V##n1[3]} + acc2B; \
                accA = accA + acc2A; accB = accB + acc2B; \
                float sA = accA.x + accA.y, sB = accB.x + accB.y; \
                sA = DPP_ADD(sA, 0xB1); sB = DPP_ADD(sB, 0xB1); sA = DPP_ADD(sA, 0x4E); sB = DPP_ADD(sB, 0x4E); sA = DPP_ADD(sA, 0x141); sB = DPP_ADD(sB, 0x141); \
                const f32x2 saA = {sA, sA}, saB = {sB, sB}, vA = {V##va, V##va}, vB = {V##vb, V##vb}; \
                const f32x2 e_0 = {V##e0[0], V##e0[1]}, e_1 = {V##e0[2], V##e0[3]}, e_2 = {V##e1[0], V##e1[1]}, e_3 = {V##e1[2], V##e1[3]}; \
                const f32x2 k_0 = {V##k0[0], V##k0[1]}, k_1 = {V##k0[2], V##k0[3]}, k_2 = {V##k1[0], V##k1[1]}, k_3 = {V##k1[2], V##k1[3]}; \
                const f32x2 d_0 = {V##d0[0], V##d0[1]}, d_1 = {V##d0[2], V##d0[3]}, d_2 = {V##d1[0], V##d1[1]}, d_3 = {V##d1[2], V##d1[3]}; \
                f32x2 tA0 = saA * e_0, tB0 = saB * e_0, tA1 = saA * e_1, tB1 = saB * e_1, tA2 = saA * e_2, tB2 = saB * e_2, tA3 = saA * e_3, tB3 = saB * e_3; \
                tA0 = vA * k_0 + tA0; tB0 = vB * k_0 + tB0; tA1 = vA * k_1 + tA1; tB1 = vB * k_1 + tB1; tA2 = vA * k_2 + tA2; tB2 = vB * k_2 + tB2; tA3 = vA * k_3 + tA3; tB3 = vB * k_3 + tB3; \
                S[0] = S[0] * d_0 + tA0; S[4] = S[4] * d_0 + tB0; S[1] = S[1] * d_1 + tA1; S[5] = S[5] * d_1 + tB1; S[2] = S[2] * d_2 + tA2; S[6] = S[6] * d_2 + tB2; S[3] = S[3] * d_3 + tA3; S[7] = S[7] * d_3 + tB3; \
                f32x2 yA = S[0] * (f32x2){V##r0[0], V##r0[1]}, yB = S[4] * (f32x2){V##r0[0], V##r0[1]}; \
                f32x2 y2A = S[2] * (f32x2){V##r1[0], V##r1[1]}, y2B = S[6] * (f32x2){V##r1[0], V##r1[1]}; \
                yA = S[1] * (f32x2){V##r0[2], V##r0[3]} + yA; yB = S[5] * (f32x2){V##r0[2], V##r0[3]} + yB; \
                y2A = S[3] * (f32x2){V##r1[2], V##r1[3]} + y2A; y2B = S[7] * (f32x2){V##r1[2], V##r1[3]} + y2B; \
                yA = yA + y2A; yB = yB + y2B; \
                float uA = yA.x + yA.y, uB = yB.x + yB.y; \
                uA = DPP_ADD(uA, 0xB1); uB = DPP_ADD(uB, 0xB1); uA = DPP_ADD(uA, 0x4E); uB = DPP_ADD(uB, 0x4E); uA = DPP_ADD(uA, 0x141); uB = DPP_ADD(uB, 0x141); \
                if (jg == 0) { Yc[yo] = uA; Yc[(yo) + 32] = uB; } } while (0)
            f32x4 Pd0, Pd1, Pn0, Pn1, Pe0, Pe1, Pk0, Pk1, Pr0, Pr1, Qd0, Qd1, Qn0, Qn1, Qe0, Qe1, Qk0, Qk1, Qr0, Qr1; float Pva, Pvb, Qva, Qvb;
            RW_LV(P, 0);
#pragma unroll 2
            for (int tl = 0; tl < TC; tl += 2) {
                RW_LV(Q, tl + 1);
                RW_ROW2(P, tl * 64);
                if (tl + 2 < TC) RW_LV(P, tl + 2);
                RW_ROW2(Q, (tl + 1) * 64);
            }
#undef RW_LV
#undef RW_ROW2
            __syncthreads();
        }
    } else {
        const int hw = wid - 4, tl = hw * 8 + (lane >> 3), c8 = 8 * (lane & 7), ch = 64 * h + c8;
        float mu_r[8], mu_k[8], mu_v[8], c_kk[8], c_ka[8], c_rk[8], c_gg[8], c_gb[8];
#pragma unroll
        for (int e = 0; e < 8; ++e) { mu_r[e] = PL->in[I_MU][ch + e]; mu_k[e] = PL->in[I_MU][1024 + ch + e]; mu_v[e] = PL->in[I_MU][2048 + ch + e];
            c_kk[e] = PL->in[I_KK][ch + e]; c_ka[e] = PL->in[I_KA][ch + e]; c_rk[e] = PL->in[I_RK][ch + e]; c_gg[e] = PL->in[I_GNG][ch + e]; c_gb[e] = PL->in[I_GNB][ch + e]; }
        bf16x8 pr, pk, pv, qr, qk, qv, pw, pa, pgt;
#define UNPK(v, e) bf2f((bf16_t)(v)[e])
#define RW_LOAD(chn) do { const int tg = (chn) * TC + tl; const size_t tok = (size_t)b * SEQ + tg; \
            const bf16_t* up = u + tok * ABP + 1536 + ch; pr = *(const bf16x8*)up; pk = *(const bf16x8*)(up + 1024); pv = *(const bf16x8*)(up + 2048); \
            if (tg > 0) { qr = *(const bf16x8*)(up - ABP); qk = *(const bf16x8*)(up + 1024 - ABP); qv = *(const bf16x8*)(up + 2048 - ABP); } \
            else { _Pragma("unroll") for (int e = 0; e < 8; ++e) { qr[e] = 0; qk[e] = 0; qv[e] = 0; } } \
            const bf16_t* lp = lo + tok * 3072 + ch; pw = *(const bf16x8*)lp; pa = *(const bf16x8*)(lp + 1024); pgt = *(const bf16x8*)(lp + 2048); } while (0)
#define RW_PREP(chn) do { LAS float* a_ = A + ((chn) & 1) * TC * 384 + tl * 384 + c8; LAS float* g_ = Gb + ((chn) & 1) * TC * 64 + tl * 64 + c8; LAS float* Bc = BON + ((chn) & 1) * TC; \
            float xr[8], kp[8], kkv[8], av[8], o0[8], o1[8], o2[8], o5[8], gg[8]; float s1 = 0.f, s2 = 0.f; \
            _Pragma("unroll") for (int e = 0; e < 8; ++e) { const float r0 = UNPK(pr, e), k0 = UNPK(pk, e), v0 = UNPK(pv, e); \
                xr[e] = r0 + (UNPK(qr, e) - r0) * mu_r[e]; const float xk = k0 + (UNPK(qk, e) - k0) * mu_k[e]; o5[e] = v0 + (UNPK(qv, e) - v0) * mu_v[e]; \
                av[e] = UNPK(pa, e); gg[e] = UNPK(pgt, e); o0[e] = fexp2(UNPK(pw, e) * LOG2E); \
                kkv[e] = xk * c_kk[e]; s1 += kkv[e] * kkv[e]; kp[e] = xk * (1.f + (av[e] - 1.f) * c_ka[e]); s2 += xr[e] * kp[e] * c_rk[e]; } \
            s1 = red8(s1); s2 = red8(s2); const float rn = 1.f / fmaxf(sqrtf(s1), 1e-12f); \
            _Pragma("unroll") for (int e = 0; e < 8; ++e) { const float kkn = kkv[e] * rn; o1[e] = -kkn; o2[e] = kkn * av[e]; } \
            *(LAS f32x4*)(a_) = (f32x4){o0[0], o0[1], o0[2], o0[3]}; *(LAS f32x4*)(a_ + 4) = (f32x4){o0[4], o0[5], o0[6], o0[7]}; \
            *(LAS f32x4*)(a_ + 64) = (f32x4){o1[0], o1[1], o1[2], o1[3]}; *(LAS f32x4*)(a_ + 68) = (f32x4){o1[4], o1[5], o1[6], o1[7]}; \
            *(LAS f32x4*)(a_ + 128) = (f32x4){o2[0], o2[1], o2[2], o2[3]}; *(LAS f32x4*)(a_ + 132) = (f32x4){o2[4], o2[5], o2[6], o2[7]}; \
            *(LAS f32x4*)(a_ + 192) = (f32x4){kp[0], kp[1], kp[2], kp[3]}; *(LAS f32x4*)(a_ + 196) = (f32x4){kp[4], kp[5], kp[6], kp[7]}; \
            *(LAS f32x4*)(a_ + 256) = (f32x4){xr[0], xr[1], xr[2], xr[3]}; *(LAS f32x4*)(a_ + 260) = (f32x4){xr[4], xr[5], xr[6], xr[7]}; \
            *(LAS f32x4*)(a_ + 320) = (f32x4){o5[0], o5[1], o5[2], o5[3]}; *(LAS f32x4*)(a_ + 324) = (f32x4){o5[4], o5[5], o5[6], o5[7]}; \
            *(LAS f32x4*)(g_) = (f32x4){gg[0], gg[1], gg[2], gg[3]}; *(LAS f32x4*)(g_ + 4) = (f32x4){gg[4], gg[5], gg[6], gg[7]}; \
            if ((lane & 7) == 0) Bc[tl] = s2; } while (0)
#define RW_POST(chn) do { const LAS float* a_ = A + ((chn) & 1) * TC * 384 + tl * 384 + 320 + c8; const LAS float* g_ = Gb + ((chn) & 1) * TC * 64 + tl * 64 + c8; \
            const LAS float* y_ = Yb + ((chn) & 1) * TC * 64 + tl * 64 + c8; const float bon = BON[((chn) & 1) * TC + tl]; \
            const f32x4 y0 = *(const LAS f32x4*)(y_), y1 = *(const LAS f32x4*)(y_ + 4), v0 = *(const LAS f32x4*)(a_), v1 = *(const LAS f32x4*)(a_ + 4), g0 = *(const LAS f32x4*)(g_), g1 = *(const LAS f32x4*)(g_ + 4); \
            float yy[8] = {y0[0], y0[1], y0[2], y0[3], y1[0], y1[1], y1[2], y1[3]}; const float vv[8] = {v0[0], v0[1], v0[2], v0[3], v1[0], v1[1], v1[2], v1[3]}; const float gq[8] = {g0[0], g0[1], g0[2], g0[3], g1[0], g1[1], g1[2], g1[3]}; \
            float sm = 0.f; _Pragma("unroll") for (int e = 0; e < 8; ++e) sm += yy[e]; const float mean = red8(sm) * (1.f / 64.f); \
            float sv = 0.f; _Pragma("unroll") for (int e = 0; e < 8; ++e) { yy[e] -= mean; sv += yy[e] * yy[e]; } const float rsd = __builtin_amdgcn_rsqf(red8(sv) * (1.f / 64.f) + 64e-5f); \
            float ov[8]; _Pragma("unroll") for (int e = 0; e < 8; ++e) ov[e] = (yy[e] * rsd * c_gg[e] + c_gb[e] + bon * vv[e]) * gq[e]; \
            u32x4 w; w.x = cvt_pk_bf16(ov[0], ov[1]); w.y = cvt_pk_bf16(ov[2], ov[3]); w.z = cvt_pk_bf16(ov[4], ov[5]); w.w = cvt_pk_bf16(ov[6], ov[7]); \
            *(u32x4*)(y + ((size_t)b * SEQ + (chn) * TC + tl) * DM + 1024 + ch) = w; } while (0)
        RW_LOAD(0); RW_PREP(0);
        __syncthreads();
        for (int chn = 0; chn < NC; ++chn) {
            if (chn + 1 < NC) RW_LOAD(chn + 1);
            if (chn > 0) RW_POST(chn - 1);
            if (chn + 1 < NC) RW_PREP(chn + 1);
            __syncthreads();
        }
        RW_POST(NC - 1);
#undef RW_LOAD
#undef RW_PREP
#undef RW_POST
#undef UNPK
    }
    __syncthreads();
}

#define XB_TMO      128
#define XB_XCNT(j)  (256  + 64 * (j))
#define XB_XSUB(j)  (1280 + 64 * (j))
#define XB_XGEN(j)  (2304 + 64 * (j))
#define XB_TOP      3328
#define XB_TOPGEN   3392
#define XCD_BAR_WORDS 3456
#define XB_SPIN_CAP (1u << 18)

__device__ __forceinline__ unsigned xb_ld(unsigned* p)              { return __hip_atomic_load(p, __ATOMIC_RELAXED, __HIP_MEMORY_SCOPE_AGENT); }
__device__ __forceinline__ unsigned xb_add(unsigned* p, unsigned v) { return __hip_atomic_fetch_add(p, v, __ATOMIC_RELAXED, __HIP_MEMORY_SCOPE_AGENT); }
__device__ __forceinline__ unsigned xb_xcc_id() { return (unsigned)__builtin_amdgcn_s_getreg((3 << 11) | 20) & 0xFu; }
#define XB_SPIN(cond, bar) do { unsigned _sp = 0; while (cond) { __builtin_amdgcn_s_sleep(1); \
    if ((++_sp & 255u) == 0u) { if (xb_ld(&(bar)[XB_TMO])) break; if (_sp > XB_SPIN_CAP) { atomicAdd(&(bar)[XB_TMO], 1u); break; } } } } while (0)

struct XcdBarrier {
    unsigned* bar; unsigned x;
    volatile LAS unsigned* st;
};

__device__ __forceinline__ XcdBarrier xcd_barrier_post(unsigned* bar, volatile LAS unsigned* st) {
    XcdBarrier b; b.bar = bar; b.x = xb_xcc_id(); b.st = st;
    if (threadIdx.x == 0) (void)xb_add(&bar[XB_XCNT(b.x)], 1u);
    return b;
}
__device__ __forceinline__ void xcd_barrier_complete(unsigned* bar, unsigned x, unsigned& nloc, unsigned& nx) {
    const unsigned G = gridDim.x * gridDim.y * gridDim.z;
    unsigned sum, cnt, mine, sp = 0u;
    for (;;) {
        sum = 0u; cnt = 0u; mine = 0u;
#pragma unroll
        for (unsigned j = 0; j < 16; ++j) { const unsigned c = xb_ld(&bar[XB_XCNT(j)]); sum += c; cnt += (c > 0u) ? 1u : 0u; mine = (j == x) ? c : mine; }
        if (sum == G) break;
        __builtin_amdgcn_s_sleep(1);
        if ((++sp & 255u) == 0u) { if (xb_ld(&bar[XB_TMO])) break; if (sp > XB_SPIN_CAP) { atomicAdd(&bar[XB_TMO], 1u); break; } }
    }
    nloc = mine > 0u ? mine : 1u; nx = cnt > 0u ? cnt : 1u;
}

__device__ __forceinline__ void xcd_barrier(const XcdBarrier& b) {
    asm volatile("s_waitcnt vmcnt(0)" ::: "memory");
    __syncthreads();
    if (threadIdx.x == 0) {
        unsigned* bar = b.bar;
        __builtin_amdgcn_s_waitcnt(0);
        unsigned nloc = b.st[0], nx = b.st[1];
        if (nloc == 0u) { xcd_barrier_complete(bar, b.x, nloc, nx); b.st[0] = nloc; b.st[1] = nx; }
        const unsigned old = xb_add(&bar[XB_XSUB(b.x)], 1u);
        const unsigned gen = old / nloc;
        if (old + 1u == (gen + 1u) * nloc) {
            __builtin_amdgcn_fence(__ATOMIC_RELEASE, "agent");
            asm volatile("s_waitcnt vmcnt(0)" ::: "memory");
            const unsigned og = xb_add(&bar[XB_TOP], 1u);
            const unsigned tg = og / nx;
            if (og + 1u == (tg + 1u) * nx) xb_add(&bar[XB_TOPGEN], 1u);
            else XB_SPIN(xb_ld(&bar[XB_TOPGEN]) == tg, bar);
            __builtin_amdgcn_fence(__ATOMIC_ACQUIRE, "agent");
            xb_add(&bar[XB_XGEN(b.x)], 1u);
            asm volatile("s_waitcnt vmcnt(0)" ::: "memory");
        } else {
            XB_SPIN(xb_ld(&bar[XB_XGEN(b.x)]) == gen, bar);
            __builtin_amdgcn_fence(__ATOMIC_ACQUIRE, "agent");
            asm volatile("s_waitcnt vmcnt(0)" ::: "memory");
        }
    }
    __syncthreads();
}

#ifndef EN_MASK
#define EN_MASK 0xFFFF
#endif
#define EN(b) ((EN_MASK >> (b)) & 1)
__global__ void __launch_bounds__(NTHREADS, 2) hybrid_fwd(Params P) {
    extern __shared__ __attribute__((aligned(16))) unsigned char lds_raw[];
    LAS unsigned char* lds = (LAS unsigned char*)lds_raw;
    cg::grid_group grid = cg::this_grid();
    const int tid0 = threadIdx.x, G0 = gridDim.x, bx0 = blockIdx.x;
    LAS Params* PLw = (LAS Params*)(lds + LDS_BYTES - 1024);
    for (int i = tid0; i < (int)(sizeof(Params) / 4); i += NTHREADS) ((LAS unsigned*)PLw)[i] = ((const unsigned*)&P)[i];
    __syncthreads();
    const LAS Params* PL = PLw;
    const int ph_lo = P.ph_lo, ph_hi = P.ph_hi;
    volatile LAS unsigned* bst = (volatile LAS unsigned*)(lds + LDS_BYTES - 1024 + 512);
    if (tid0 < 2) bst[tid0] = 0u;
    __syncthreads();
    XcdBarrier xbar = xcd_barrier_post((unsigned*)(P.ws + WS_BAR), bst);
#ifndef REP_MASK
#define REP_MASK 0
#endif
    unsigned rep_mask = REP_MASK; (void)rep_mask;
    for (int ph = ph_lo; ph < ph_hi; ++ph) {
#define ROOTS int tid = tid0, G = G0, bx = bx0; unsigned char* ws = P.ws; \
        asm volatile("" : "+v"(tid)); asm volatile("" : "+s"(G)); asm volatile("" : "+s"(bx)); asm volatile("" : "+s"(ws)); \
        const int lane = tid & 63, wave = __builtin_amdgcn_readfirstlane(tid >> 6); const int gw = bx * 8 + wave, NGW = G * 8; \
        ssq_t* ssb = (ssq_t*)(ws + WS_SS); f32x2* cs64 = (f32x2*)(ws + WS_CS64); f32x2* cs32 = (f32x2*)(ws + WS_CS32); bf16_t* xb = (bf16_t*)(ws + WS_XB); unsigned char* big = ws + WS_BIG; \
        (void)lane; (void)gw; (void)NGW; (void)ssb; (void)cs64; (void)cs32; (void)xb; (void)big;
        const int L = ph >= 14 ? 1 : 0;
        int kind = 0, nsub = 1;
        if (ph == 1 || ph == 4 || ph == 9 || ph == 16 || ph == 17 || ph == 21) kind = 1;
        if (ph == 2 || ph == 12 || ph == 14 || ph == 24) kind = 2;
        if (ph == 3 || ph == 8 || ph == 11 || ph == 13 || ph == 15 || ph == 20 || ph == 23 || ph == 25) kind = 3;
        if (ph == 6) kind = 4;
        if (ph == 17) nsub = 2;

        if (EN(0) && ph == 0) { ROOTS
            for (int i = bx * NTHREADS + tid; i < MT * 10; i += G * NTHREADS) { const int bsel = i / MT; const int bi = bsel < 9 ? 1 + bsel : SS_DUMMY; ssb[(size_t)bi * MT + (i % MT)] = 0u; }
            LAS float* scr = (LAS float*)(lds + wave * 16384);
            conv_ffn(PL, 0, 0, scr, lane, gw, NGW);
            conv_ffn(PL, 0, 1, scr, lane, gw, NGW);
            conv_matrix(PL->in[I_ABIN], DM, ABN, PL->in[I_MIXN], (bf16_t*)(ws + WS_WABIN), DM, 0, 0, scr, lane, gw, NGW);
            conv_matrix(PL->in[I_ABOUT], DM, DM, nullptr, (bf16_t*)(ws + WS_WABOUT), DM, 0, 0, scr, lane, gw, NGW);
            conv_matrix(PL->in[I_CDIN], DM, CDN, PL->in[I_MIXN] + DM, (bf16_t*)(ws + WS_WCDIN), DM, 0, 0, scr, lane, gw, NGW);
            conv_matrix(PL->in[I_CDOUT], DM, DM, nullptr, (bf16_t*)(ws + WS_WCDOUT), DM, 0, 0, scr, lane, gw, NGW);
            conv_matrix(PL->in[I_WUQ], 512, 1536, PL->in[I_CQN], (bf16_t*)(ws + WS_WUQ), 512, 0, 0, scr, lane, gw, NGW);
            conv_matrix(PL->in[I_WUKV], 256, 2048, PL->in[I_CKVN], (bf16_t*)(ws + WS_WUKV), 256, 0, 0, scr, lane, gw, NGW);
            for (int l2 = 0; l2 < 2; ++l2) {
                conv_matrix(PL->in[I_MXWQ] + (size_t)l2 * DM * 512, DM, 512, PL->in[I_MXN] + l2 * DM, (bf16_t*)(ws + WS_WMQ) + (size_t)l2 * 512 * DM, DM, 0, 0, scr, lane, gw, NGW);
                conv_matrix(PL->in[I_MXWO] + (size_t)l2 * 512 * DM, 512, DM, nullptr, (bf16_t*)(ws + WS_WMO) + (size_t)l2 * DM * 512, 512, 0, 0, scr, lane, gw, NGW);
            }
            conv_matrix(PL->in[I_MEMWKV], DM, 1024, PL->in[I_MEMN], (bf16_t*)(ws + WS_WMKV), DM, 0, 0, scr, lane, gw, NGW);
            { bf16_t* wl = (bf16_t*)(ws + WS_WLORA);
              for (int i = bx * NTHREADS + tid; i < 3072 * 512; i += G * NTHREADS) { const int n = i >> 9, k = i & 511; float v = 0.f;
                  if (n < 1024) { if (k < 64) v = PL->in[I_W2][k * 1024 + n]; }
                  else if (n < 2048) { if (k >= 128 && k < 192) v = PL->in[I_A2][(k - 128) * 1024 + n - 1024]; }
                  else { if (k >= 256 && k < 416) v = PL->in[I_G2][(k - 256) * 1024 + n - 2048]; }
                  wl[i] = f2bf(v); } }
            for (int row = gw; row < MT; row += NGW) row_to_bf16(PL->in[I_X] + (size_t)row * DM, xb + (size_t)row * DM, ssb + (size_t)SS_A0 * MT + row, lane);
            for (int row = gw; row < NB * MEML; row += NGW) row_to_bf16(PL->in[I_MEM] + (size_t)row * DM, (bf16_t*)(ws + WS_MEMB) + (size_t)row * DM, ssb + (size_t)SS_MEM * MT + row, lane);
            { const int* pos = (const int*)PL->in[I_POS];
              for (int i = bx * NTHREADS + tid; i < MT * 48; i += G * NTHREADS) { const int tok = i / 48, j = i % 48; const bool big64 = j < 32; const int fi = big64 ? j : j - 32;
                  const float e = big64 ? (float)(2 * fi) / 64.f : (float)(2 * fi) / 32.f;
                  const float inv = 1.0f / powf(10000.0f, e);
                  const float ang = (float)pos[tok] * inv;
                  const double rev = (double)ang * 0.15915494309189535; const float fr = (float)(rev - rint(rev));
                  const f32x2 t = {__builtin_amdgcn_cosf(fr), __builtin_amdgcn_sinf(fr)};
                  if (big64) cs64[(size_t)tok * 32 + fi] = t; else cs32[(size_t)tok * 16 + fi] = t; } }
        }
        if (EN(1) && ph == 2) { ROOTS
            bf16_t* mkv = (bf16_t*)(ws + WS_MEMKV);
            for (int it = gw; it < NB * MEML * 4; it += NGW) { const int row = it >> 2, hd = it & 3; bf16_t* p = mkv + (size_t)row * 1024 + hd * 128;
                const float x0 = bf2f(p[lane]), x1 = bf2f(p[64 + lane]); const float ss = wave_sum(x0 * x0 + x1 * x1); const float rs = __builtin_amdgcn_rsqf(ss / 128.f + EPS);
                p[lane] = f2bf(x0 * rs * PL->in[I_MEMKN][lane]); p[64 + lane] = f2bf(x1 * rs * PL->in[I_MEMKN][64 + lane]); }
            __syncthreads();
        }
        for (int sub = 0; sub < nsub; ++sub) {
            if (kind == 0) break;
            ROOTS
            pg8::Gemm g; pg8::EpiAny E; E.kind = kind; E.perm = (kind != 3); E.O = nullptr; E.ldc = 0; E.ss = nullptr; E.inv_k = 1.f / DM; E.p0 = nullptr; E.p1 = nullptr;
            if (kind == 1) {
                if (ph == 1) { g = {(const bf16_t*)(ws + WS_MEMB), (const bf16_t*)(ws + WS_WMKV), NB * MEML, 1024, DM, DM}; E.O = (bf16_t*)(ws + WS_MEMKV); E.ldc = 1024; E.ss = ssb + (size_t)SS_MEM * MT; }
                else if (ph == 4) { g = {xb, (const bf16_t*)(ws + WS_WABIN), MT, ABP, DM, DM}; E.O = (bf16_t*)(big + B0_U); E.ldc = ABP; E.ss = ssb + (size_t)SS_B0 * MT; }
                else if (ph == 16) { g = {xb, (const bf16_t*)(ws + WS_WCDIN), MT, CDP, DM, DM}; E.O = (bf16_t*)(big + B1_U); E.ldc = CDP; E.ss = ssb + (size_t)SS_B1 * MT; E.p0 = ssb + (size_t)SS_CQ * MT; E.p1 = ssb + (size_t)SS_CKV * MT; }
                else if (ph == 17 && sub == 0) { g = {(const bf16_t*)(big + B1_U), (const bf16_t*)(ws + WS_WUQ), MT, 1536, 512, CDP}; E.O = (bf16_t*)(big + B1_Q); E.ldc = 1536; E.ss = ssb + (size_t)SS_CQ * MT; E.inv_k = 1.f / 512.f; }
                else if (ph == 17) { g = {(const bf16_t*)(big + B1_U) + 512, (const bf16_t*)(ws + WS_WUKV), MT, 2048, 256, CDP}; E.O = (bf16_t*)(big + B1_KV); E.ldc = 2048; E.ss = ssb + (size_t)SS_CKV * MT; E.inv_k = 1.f / 256.f; }
                else { g = {xb, (const bf16_t*)(ws + WS_WMQ) + (size_t)L * 512 * DM, MT, 512, DM, DM}; E.O = (bf16_t*)(big + BM_Q); E.ldc = 512; E.ss = ssb + (size_t)(L ? SS_C1 : SS_C0) * MT; }
            } else if (kind == 2) {
                const bool second = (ph == 12 || ph == 24);
                g = {xb, (const bf16_t*)(ws + (ph == 24 ? WS_WGUC : second ? WS_WGUB : WS_WGUA)), MT, 2 * FF, DM, DM};
                E.O = (bf16_t*)(big + B_H); E.ldc = FF;
                E.ss = ssb + (size_t)(ph == 2 ? SS_A0 : ph == 12 ? SS_D0 : ph == 14 ? SS_A1 : SS_D1) * MT;
            } else if (kind == 3) {
                float* outp = PL->out;
                E.ss = outp; E.p0 = outp; E.O = xb; E.ldc = DM; E.inv_k = 1.f;
                if (ph == 3 || ph == 15) { g = {(const bf16_t*)(big + B_H), (const bf16_t*)(ws + WS_WDA), MT, DM, FF, FF}; E.inv_k = 0.5f; E.p1 = ssb + (size_t)(ph == 3 ? SS_B0 : SS_B1) * MT; if (ph == 3) E.ss = PL->in[I_X]; }
                else if (ph == 13 || ph == 25) { g = {(const bf16_t*)(big + B_H), (const bf16_t*)(ws + (ph == 25 ? WS_WDC : WS_WDB)), MT, DM, FF, FF}; E.inv_k = 0.5f; E.p1 = ssb + (size_t)(ph == 13 ? SS_A1 : SS_DUMMY) * MT; if (ph == 25) E.O = nullptr; }
                else if (ph == 8) { g = {(const bf16_t*)(big + B0_Y), (const bf16_t*)(ws + WS_WABOUT), MT, DM, DM, DM}; E.p1 = ssb + (size_t)SS_C0 * MT; }
                else if (ph == 20) { g = {(const bf16_t*)(big + B1_Y), (const bf16_t*)(ws + WS_WCDOUT), MT, DM, DM, DM}; E.p1 = ssb + (size_t)SS_C1 * MT; }
                else { g = {(const bf16_t*)(big + BM_O), (const bf16_t*)(ws + WS_WMO) + (size_t)L * DM * 512, MT, DM, 512, 512}; E.p1 = ssb + (size_t)(L ? SS_D1 : SS_D0) * MT; }
            } else {
                g = {(const bf16_t*)(big + B0_LIN), (const bf16_t*)(ws + WS_WLORA), MT, 3072, 512, 512};
                E.O = (bf16_t*)(big + B0_LOUT); E.ldc = 3072; E.p0 = (void*)PL->in[I_W0]; E.p1 = (void*)PL->in[I_A0];
            }
#if REP_MASK
            if (kind == 3 && ((rep_mask >> ph) & 1u)) { E.inv_k = 0.f; E.p1 = ssb + (size_t)SS_DUMMY * MT; }
#endif
            pg8::StaticOrder S; S.init(g.M, g.N, G, bx);
            pg8::gemm_phase<pg8::EpiAny, pg8::StaticOrder, true, true>(lds, g, S, E, tid);
        }
        if (EN(6) && ph == 5) { ROOTS
            bf16_t* u = (bf16_t*)(big + B0_U);
            for (int tok = gw; tok < MT; tok += NGW) { bf16_t* p = u + (size_t)tok * ABP; const f32x2* c64 = cs64 + (size_t)tok * 32;
                norm_rope_row<64>(p + 1024, 64, 4, PL->in[I_SWAKN], c64, lane); }
            { bf16_t* lin = (bf16_t*)(big + B0_LIN);
              int dcol, kindc = 0; const int s8 = 8 * lane;
              if (lane < 36) { dcol = s8 < 64 ? s8 : (s8 < 128 ? 128 + (s8 - 64) : 256 + (s8 - 128)); kindc = s8 < 64 ? 0 : (s8 < 128 ? 1 : 2); }
              else { const int pz = lane - 36; dcol = pz < 8 ? 64 + 8 * pz : (pz < 16 ? 192 + 8 * (pz - 8) : 416 + 8 * (pz - 16)); }
              float mu8[8];
#pragma unroll
              for (int e = 0; e < 8; ++e) mu8[e] = lane < 36 ? PL->in[I_MU][3072 + s8 + e] : 0.f;
              for (int tok = gw; tok < MT; tok += NGW) {
                  u32x4 w = {0u, 0u, 0u, 0u};
                  if (lane < 36) { const bf16_t* up = u + (size_t)tok * ABP + 4608 + s8; const bf16x8 pc = *(const bf16x8*)up; bf16x8 pp;
                      if ((tok % SEQ) != 0) pp = *(const bf16x8*)(up - ABP); else {
#pragma unroll
                          for (int e = 0; e < 8; ++e) pp[e] = 0; }
                      float v[8];
#pragma unroll
                      for (int e = 0; e < 8; ++e) { const float c0 = bf2f((bf16_t)pc[e]); const float xs = c0 + (bf2f((bf16_t)pp[e]) - c0) * mu8[e];
                          v[e] = kindc == 0 ? tanhf(xs) : (kindc == 1 ? xs : 1.f / (1.f + __expf(-xs))); }
                      w.x = cvt_pk_bf16(v[0], v[1]); w.y = cvt_pk_bf16(v[2], v[3]); w.z = cvt_pk_bf16(v[4], v[5]); w.w = cvt_pk_bf16(v[6], v[7]); }
                  *(u32x4*)(lin + (size_t)tok * 512 + dcol) = w; } }
        }
        if (EN(7) && ph == 7) { ROOTS
            const int nscan = G / 2;
            if (EN(8) && bx < nscan) { for (int un = bx; un < NB * 16; un += nscan) rwkv_unit(lds, PL, un >> 4, un & 15, tid); }
            else {
                const bf16_t* u = (const bf16_t*)(big + B0_U); bf16_t* y = (bf16_t*)(big + B0_Y);
                const int nsw = G - nscan; const int vsw = ((nsw & 7) == 0 && (nscan & 7) == 0) ? ((bx & 7) * (nsw >> 3) + ((bx - nscan) >> 3)) : (bx - nscan);
                for (int un = vsw; un < NB * 16 * 8; un += nsw) { const int qb = un & 7, hd = (un >> 3) & 15, b = un >> 7;
                    AttSrc s; s.q = u + (size_t)b * SEQ * ABP + hd * 64; s.qp = ABP; s.ka = u + (size_t)b * SEQ * ABP + 1024 + (hd >> 2) * 64; s.kap = ABP; s.kb = s.ka; s.kbp = ABP;
                    s.v = u + (size_t)b * SEQ * ABP + 1280 + (hd >> 2) * 64; s.vp = ABP; s.SK = SEQ;
                    f32x16 o[2];
                    s.qcs = cs64 + (size_t)b * SEQ * 32;
                    attn_unit<64, 0, 64, 1>(lds, s, qb * 256, 0.125f * LOG2E, PL->in[I_SINKS][hd] * LOG2E, PL->in[I_SWAQN], o, tid);
                    attn_store<64>(o, y + ((size_t)b * SEQ + qb * 256 + wave * 32 + (lane & 31)) * DM + hd * 64, lane >> 5); }
                const int gw2 = (bx - nscan) * 8 + wave, NGW2 = (G - nscan) * 8;
                conv_ffn(PL, 1, 0, (LAS float*)(lds + wave * 16384), lane, gw2, NGW2);
                conv_ffn(PL, 1, 1, (LAS float*)(lds + wave * 16384), lane, gw2, NGW2);
            }
        }
        if (EN(9) && (ph == 10 || ph == 22)) { ROOTS
            const bf16_t* mq = (const bf16_t*)(big + BM_Q); bf16_t* mo = (bf16_t*)(big + BM_O);
            const int vbm = (G & 7) == 0 ? ((bx & 7) * (G >> 3) + (bx >> 3)) : bx;
            for (int un = vbm; un < NB * 4 * 8; un += G) { const int qb = un & 7, hd = (un >> 3) & 3, b = un >> 5;
                AttSrc s; s.q = mq + (size_t)b * SEQ * 512 + hd * 128; s.qp = 512; s.ka = (const bf16_t*)(ws + WS_MEMKV) + (size_t)b * MEML * 1024 + hd * 128; s.kap = 1024; s.kb = s.ka; s.kbp = 1024;
                s.v = (const bf16_t*)(ws + WS_MEMKV) + (size_t)b * MEML * 1024 + 512 + hd * 128; s.vp = 1024; s.SK = MEML;
                f32x16 o[4];
                attn_unit<128, 0, 128, 2>(lds, s, qb * 256, 0.08838834764831845f * LOG2E, 0.f, PL->in[I_MXQN] + L * 128, o, tid);
                attn_store<128>(o, mo + ((size_t)b * SEQ + qb * 256 + wave * 32 + (lane & 31)) * 512 + hd * 128, lane >> 5); }
        }
        if (EN(10) && ph == 18) { ROOTS
            bf16_t* u = (bf16_t*)(big + B1_U); bf16_t* q = (bf16_t*)(big + B1_Q); bf16_t* kv = (bf16_t*)(big + B1_KV);
            for (int tok = gw; tok < MT; tok += NGW) { const f32x2* c64 = cs64 + (size_t)tok * 32; const f32x2* c32 = cs32 + (size_t)tok * 16;
                norm_rope_row<64>(kv + (size_t)tok * 2048, 128, 16, PL->in[I_KNOPEN], nullptr, lane);
                norm_rope_row<32>(u + (size_t)tok * CDP + 768, 32, 1, PL->in[I_KROPEN], c32, lane);
                norm_rope_row<64>(u + (size_t)tok * CDP + 1824, 64, 16, PL->in[I_DKN], c64, lane); }
        }
        if (EN(11) && ph == 19) { ROOTS
            const bf16_t* u = (const bf16_t*)(big + B1_U); const bf16_t* q = (const bf16_t*)(big + B1_Q); const bf16_t* kv = (const bf16_t*)(big + B1_KV); bf16_t* y = (bf16_t*)(big + B1_Y);
            const int vb = (G & 7) == 0 ? ((bx & 7) * (G >> 3) + (bx >> 3)) : bx;
            for (int un = vb; un < NB * 16 * 8; un += G) {
                int bh, qb;
                if (G == 256) { const int i = un >> 8; bh = vb >> 1; const int base = (vb & 1) ? 1 : 0; qb = (i == 0) ? base : (i == 1) ? 7 - base : (i == 2) ? 3 - base : 4 + base; }
                else { bh = un >> 3; qb = un & 7; }
                const int b = bh >> 4, hd = bh & 15;
                AttSrc s; s.q = q + (size_t)b * SEQ * 1536 + hd * 96; s.qp = 1536; s.ka = kv + (size_t)b * SEQ * 2048 + hd * 128; s.kap = 2048; s.kb = u + (size_t)b * SEQ * CDP + 768; s.kbp = CDP;
                s.v = kv + (size_t)b * SEQ * 2048 + hd * 128 + 64; s.vp = 2048; s.SK = SEQ;
                f32x16 o[2];
                s.qcs = cs32 + (size_t)b * SEQ * 16; s.qg2 = PL->in[I_QROPEN];
                attn_unit<64, 32, 64, 0>(lds, s, qb * 256, 0.10206207261596577f * LOG2E, 0.f, PL->in[I_QNOPEN], o, tid);
                attn_store<64>(o, y + ((size_t)b * SEQ + qb * 256 + wave * 32 + (lane & 31)) * DM + hd * 64, lane >> 5);
            }
            const float lam = __expf(wave_sum(PL->in[I_LQ1][lane] * PL->in[I_LK1][lane])) - __expf(wave_sum(PL->in[I_LQ2][lane] * PL->in[I_LK2][lane])) + LAMBDA_INIT;
            if (EN(12)) for (int un = vb; un < NB * 8 * 8; un += G) {
                int bh, qb;
                if (G == 256) { const int i = un >> 8; bh = vb >> 2; qb = i == 0 ? (vb & 3) : 7 - (vb & 3); }
                else { bh = un >> 3; qb = un & 7; }
                const int b = bh >> 3, hd = bh & 7;
                AttSrc s; s.qp = CDP; s.kap = CDP; s.kbp = CDP; s.SK = SEQ; s.qcs = cs64 + (size_t)b * SEQ * 32; s.v = u + (size_t)b * SEQ * CDP + 2848 + hd * 128; s.vp = CDP;
                s.q = u + (size_t)b * SEQ * CDP + 800 + (2 * hd) * 64; s.ka = u + (size_t)b * SEQ * CDP + 1824 + (2 * hd) * 64; s.kb = s.ka;
                f32x16 o1[4];
                f32x4* stash = (f32x4*)(ws + WS_XB) + (size_t)bx * NTHREADS + tid;
                attn_unit<64, 0, 128, 0>(lds, s, qb * 256, 0.125f * LOG2E, 0.f, PL->in[I_DQN], o1, tid);
#pragma unroll
                for (int d = 0; d < 4; ++d)
#pragma unroll
                    for (int i4 = 0; i4 < 4; ++i4) stash[(size_t)(d * 4 + i4) * G * NTHREADS] = (f32x4){o1[d][4 * i4], o1[d][4 * i4 + 1], o1[d][4 * i4 + 2], o1[d][4 * i4 + 3]};
                s.q += 64; s.ka += 64; s.kb = s.ka;
                attn_unit<64, 0, 128, 0>(lds, s, qb * 256, 0.125f * LOG2E, 0.f, PL->in[I_DQN], o1, tid);
                float ssq = 0.f;
#pragma unroll
                for (int d = 0; d < 4; ++d)
#pragma unroll
                    for (int i4 = 0; i4 < 4; ++i4) { const f32x4 a = stash[(size_t)(d * 4 + i4) * G * NTHREADS];
#pragma unroll
                        for (int j = 0; j < 4; ++j) { const float v = a[j] - lam * o1[d][4 * i4 + j]; o1[d][4 * i4 + j] = v; ssq += v * v; }
                        if (i4 == 3) asm volatile("" ::: "memory"); }
                ssq += __shfl_xor(ssq, 32);
                const float rs = __builtin_amdgcn_rsqf(ssq / 128.f + EPS) * (1.f - LAMBDA_INIT);
                const int hh = lane >> 5;
                bf16_t* yrow = y + ((size_t)b * SEQ + qb * 256 + wave * 32 + (lane & 31)) * DM + 1024 + hd * 128;
#pragma unroll
                for (int d = 0; d < 4; ++d) {
#pragma unroll
                    for (int i4 = 0; i4 < 4; ++i4) {
                        const f32x4 g4 = *(const f32x4*)(PL->in[I_SUBLN] + 32 * d + 8 * i4 + 4 * hh);
                        u32x2 w; w.x = cvt_pk_bf16(o1[d][4 * i4] * rs * g4[0], o1[d][4 * i4 + 1] * rs * g4[1]); w.y = cvt_pk_bf16(o1[d][4 * i4 + 2] * rs * g4[2], o1[d][4 * i4 + 3] * rs * g4[3]);
                        *(u32x2*)(yrow + 32 * d + 8 * i4 + 4 * hh) = w;
                    }
                    asm volatile("" ::: "memory");
                }
            }
        }
#if REP_MASK
        if ((rep_mask >> ph) & 1u) { rep_mask &= ~(1u << ph); --ph; xcd_barrier(xbar); continue; }
#endif
        if (ph + 1 < ph_hi) { if (ph_hi > 1000) grid.sync(); else xcd_barrier(xbar); }
    }
}

#ifndef MK_PER_PHASE
#define MK_PER_PHASE 0
#endif
extern "C" void kernel_launch(void* const* d_in, const int* in_sizes, int n_in, void* d_out, int out_size, void* d_ws, size_t ws_size, hipStream_t stream) {
    static int grid = 0;
    if (grid == 0) {
        if (n_in != N_IN || out_size != MT * DM || ws_size < WS_END) { fprintf(stderr, "kernel_launch: unexpected problem (n_in %d, out %d, ws %zu, need %zu)\n", n_in, out_size, ws_size, (size_t)WS_END); grid = -1; return; }
        int dev = 0, cus = 0, per_cu = 0;
        hipGetDevice(&dev); hipDeviceGetAttribute(&cus, hipDeviceAttributeMultiprocessorCount, dev);
        if (hipFuncSetAttribute((const void*)hybrid_fwd, hipFuncAttributeMaxDynamicSharedMemorySize, LDS_BYTES) != hipSuccess) { fprintf(stderr, "kernel_launch: hipFuncSetAttribute failed\n"); grid = -1; return; }
        hipOccupancyMaxActiveBlocksPerMultiprocessor(&per_cu, (const void*)hybrid_fwd, NTHREADS, LDS_BYTES);
        (void)hipGetLastError();
        if (per_cu < 1) per_cu = 1;
        grid = cus;
        fprintf(stderr, "kernel_launch: %d CUs, occupancy %d per CU, grid %d, ws %zu\n", cus, per_cu, grid, ws_size);
    }
    if (grid < 0) return;
    (void)hipMemsetAsync((unsigned char*)d_ws + WS_BAR, 0, 16384, stream);
    Params p{};
    for (int i = 0; i < N_IN; ++i) p.in[i] = (const float*)d_in[i];
    p.out = (float*)d_out; p.ws = (unsigned char*)d_ws;
#if MK_PER_PHASE
    for (int ph = 0; ph < NPHASE; ++ph) { p.ph_lo = ph; p.ph_hi = ph + 1; hipLaunchKernelGGL(hybrid_fwd, dim3(grid), dim3(NTHREADS), LDS_BYTES, stream, p); }
#else
    p.ph_lo = 0; p.ph_hi = NPHASE;
    void* args[] = {&p};
    hipError_t e = hipLaunchCooperativeKernel((const void*)hybrid_fwd, dim3(grid), dim3(NTHREADS), args, LDS_BYTES, stream);
    if (e != hipSuccess) fprintf(stderr, "cooperative launch failed: %s (grid %d)\n", hipGetErrorString(e), grid);
#endif
}
```

```cpp
#include <hip/hip_runtime.h>
#include <hip/hip_cooperative_groups.h>
#include <cstdio>
#include <cstdint>
#include <cmath>
namespace cg = cooperative_groups;
namespace pg8 {
#define PG8_LAS __attribute__((address_space(3)))
typedef unsigned short bf16_t;
typedef short bf16x8 __attribute__((ext_vector_type(8)));
typedef float f32x4 __attribute__((ext_vector_type(4)));
typedef unsigned u32x4 __attribute__((ext_vector_type(4)));
constexpr int BM = 256, BK = 64, HALF = 128, HTB = HALF * BK * 2  , STAGE_BYTES = 8 * HTB, NXCD = 8, WGM = 4;

__host__ __device__ __forceinline__ int lds_byte(int r, int c) { const int st = (r >> 4) * 2 + (c >> 5), rr = r & 15, cc = c & 31, ob = rr * 64 + cc * 2; return st * 1024 + (ob ^ (((ob >> 9) & 1) << 5)); }
__host__ __device__ __forceinline__ void stage_rc(int b, int& R, int& C) { const int st = b / 1024, sb = b % 1024, swz = sb ^ (((sb >> 9) & 1) << 5); R = (st >> 1) * 16 + swz / 64; C = (st & 1) * 32 + (swz % 64) / 2; }
__host__ __device__ __forceinline__ int perm32(int rho) { const int n = rho >> 4, i = rho & 15; return 8 * (i >> 2) + 4 * n + (i & 3); }

struct Unit { int pm, pn; };
struct Gemm { const bf16_t* A; const bf16_t* Bt; int M, N, K, lda; };

struct StaticOrder {
    int nM, nN, nwg, G, c;
    __host__ __device__ void init(int M, int N, int G_, int c_) { nM = M / BM; nN = N / BM; nwg = nM * nN; G = G_; c = c_; }
    __host__ __device__ bool next(int i, Unit& u) const {
        const long L = (long)i * G + c; if (L >= nwg) return false;
        int wgid = (int)L; { const int q = nwg / NXCD, r = nwg % NXCD, xcd = wgid % NXCD, off = wgid / NXCD; wgid = (xcd < r ? xcd * (q + 1) : r * (q + 1) + (xcd - r) * q) + off; }
        const int nig = WGM * nN, gid = wgid / nig, fm = gid * WGM, gsz = (nM - fm) < WGM ? (nM - fm) : WGM;
        u.pm = fm + ((wgid % nig) % gsz); u.pn = (wgid % nig) / gsz; return true;
    }
    __device__ __forceinline__ void a_ready(const Unit&) const {}
    __device__ __forceinline__ void done(const Unit&) const {}
};


typedef float f32x2 __attribute__((ext_vector_type(2)));
typedef __bf16 bf16x2_t __attribute__((ext_vector_type(2)));
typedef unsigned u32x2 __attribute__((ext_vector_type(2)));
__device__ __forceinline__ unsigned cvt_pk_bf16(float lo, float hi) { f32x2 v = {lo, hi}; bf16x2_t b = __builtin_convertvector(v, bf16x2_t); return __builtin_bit_cast(unsigned, b); }
constexpr float RMS_EPS = 1e-6f;
typedef unsigned ssq_t;
constexpr float SSQ_SCALE = 4096.f, SSQ_INV = 1.f / 4096.f;
__device__ __forceinline__ void ssq_add(ssq_t* p, float q) { atomicAdd(p, (ssq_t)(q * SSQ_SCALE + 0.5f)); }
__device__ __forceinline__ float ssq_rs(const ssq_t* p, float inv_k) { return __builtin_amdgcn_rsqf((float)(*p) * (inv_k * SSQ_INV) + RMS_EPS); }

struct EpiStore {
    static constexpr bool PERM = true, AFTER_DRAIN = false;
    bf16_t* O; int ldc; const ssq_t* ss; float inv_k; ssq_t* sq0; ssq_t* sq1;
    __device__ __forceinline__ void operator()(const f32x4 (&acc)[2][2][4][2], const Unit& u, int wr, int wc, int fr, int fq) const {
        const int row0 = u.pm * BM + wr * 64 + fr, col0 = u.pn * BM + wc * 32 + 8 * fq;
        ssq_t* sq = sq0 ? (u.pn < 2 ? sq0 : (u.pn == 2 ? sq1 : nullptr)) : nullptr;
#pragma unroll
        for (int ai = 0; ai < 2; ++ai)
#pragma unroll
            for (int m = 0; m < 4; ++m) {
                const int row = row0 + ai * HALF + m * 16;
                const float rs = ss ? ssq_rs(ss + row, inv_k) : 1.f;
                float q = 0.f;
#pragma unroll
                for (int bj = 0; bj < 2; ++bj) {
                    const f32x4 v0 = acc[ai][bj][m][0] * rs, v1 = acc[ai][bj][m][1] * rs;
                    q += (v0[0] * v0[0] + v0[1] * v0[1]) + (v0[2] * v0[2] + v0[3] * v0[3]) + (v1[0] * v1[0] + v1[1] * v1[1]) + (v1[2] * v1[2] + v1[3] * v1[3]);
                    u32x4 w; w.x = cvt_pk_bf16(v0[0], v0[1]); w.y = cvt_pk_bf16(v0[2], v0[3]); w.z = cvt_pk_bf16(v1[0], v1[1]); w.w = cvt_pk_bf16(v1[2], v1[3]);
                    *(u32x4*)(O + (size_t)row * ldc + col0 + bj * HALF) = w;
                }
                if (sq) { q += __shfl_xor(q, 16); q += __shfl_xor(q, 32); if (fq == 0) ssq_add(sq + row, q); }
            }
    }
};
struct EpiLora {
    static constexpr bool PERM = true, AFTER_DRAIN = false;
    bf16_t* O; int ldc; const float* w0; const float* a0;
    __device__ __forceinline__ void operator()(const f32x4 (&acc)[2][2][4][2], const Unit& u, int wr, int wc, int fr, int fq) const {
        const int row0 = u.pm * BM + wr * 64 + fr, col0 = u.pn * BM + wc * 32 + 8 * fq;
        const int kind = u.pn >> 2;
#pragma unroll
        for (int bj = 0; bj < 2; ++bj) {
            const int c = col0 + bj * HALF;
            float bias[8];
#pragma unroll
            for (int j = 0; j < 8; ++j) bias[j] = kind == 0 ? w0[c + j] : (kind == 1 ? a0[c - 1024 + j] : 0.f);
#pragma unroll
            for (int ai = 0; ai < 2; ++ai)
#pragma unroll
                for (int m = 0; m < 4; ++m) {
                    const int row = row0 + ai * HALF + m * 16;
                    float v[8];
#pragma unroll
                    for (int j = 0; j < 8; ++j) {
                        const float t = acc[ai][bj][m][j >> 2][j & 3] + bias[j];
                        const float sg = __builtin_amdgcn_rcpf(1.f + __builtin_amdgcn_exp2f(-1.4426950408889634f * t));
                        v[j] = kind == 0 ? -0.6065306597126334f * sg : (kind == 1 ? sg : t);
                    }
                    u32x4 w; w.x = cvt_pk_bf16(v[0], v[1]); w.y = cvt_pk_bf16(v[2], v[3]); w.z = cvt_pk_bf16(v[4], v[5]); w.w = cvt_pk_bf16(v[6], v[7]);
                    *(u32x4*)(O + (size_t)row * ldc + c) = w;
                }
        }
    }
};
struct EpiSwiGLU {
    static constexpr bool PERM = true, AFTER_DRAIN = false;
    bf16_t* O; int ldc; const ssq_t* ss; float inv_k;
    __device__ __forceinline__ void operator()(const f32x4 (&acc)[2][2][4][2], const Unit& u, int wr, int wc, int fr, int fq) const {
        const int row0 = u.pm * BM + wr * 64 + fr, col0 = u.pn * HALF + wc * 32 + 8 * fq;
#pragma unroll
        for (int ai = 0; ai < 2; ++ai)
#pragma unroll
            for (int m = 0; m < 4; ++m) {
                const int row = row0 + ai * HALF + m * 16;
                const float rs = ssq_rs(ss + row, inv_k);
                float hv[8];
#pragma unroll
                for (int j = 0; j < 8; ++j) {
                    const float gt = acc[ai][0][m][j >> 2][j & 3] * rs, up = acc[ai][1][m][j >> 2][j & 3] * rs;
                    hv[j] = gt * __builtin_amdgcn_rcpf(1.f + __builtin_amdgcn_exp2f(-1.4426950408889634f * gt)) * up;
                }
                u32x4 w; w.x = cvt_pk_bf16(hv[0], hv[1]); w.y = cvt_pk_bf16(hv[2], hv[3]); w.z = cvt_pk_bf16(hv[4], hv[5]); w.w = cvt_pk_bf16(hv[6], hv[7]);
                *(u32x4*)(O + (size_t)row * ldc + col0) = w;
            }
    }
};
struct EpiResid {
    static constexpr bool PERM = false, AFTER_DRAIN = false;
    const float* base; float* out; bf16_t* xb; ssq_t* sq; int ldc; float scale;
    __device__ __forceinline__ void operator()(const f32x4 (&acc)[2][2][4][2], const Unit& u, int wr, int wc, int fr, int fq) const {
        const int row0 = u.pm * BM + wr * 64 + fr, col0 = u.pn * BM + wc * 32 + 4 * fq;
        f32x4 bv[4][4];
#define ER_LOAD(gi) do { const size_t off_ = (size_t)(row0 + ((gi) >> 2) * HALF + ((gi) & 3) * 16) * ldc + col0; \
        _Pragma("unroll") for (int q_ = 0; q_ < 4; ++q_) bv[(gi) & 3][q_] = *(const f32x4*)(base + off_ + (q_ >> 1) * HALF + (q_ & 1) * 16); } while (0)
        ER_LOAD(0); ER_LOAD(1); ER_LOAD(2);
#pragma unroll
        for (int gi = 0; gi < 8; ++gi) {
            if (gi + 3 < 8) ER_LOAD(gi + 3);
            const int ai = gi >> 2, m = gi & 3;
            const size_t off = (size_t)(row0 + ai * HALF + m * 16) * ldc + col0;
            float q = 0.f;
#pragma unroll
            for (int qq = 0; qq < 4; ++qq) {
                const int bj = qq >> 1, n = qq & 1;
                const size_t o2 = off + bj * HALF + n * 16;
                const f32x4 o = bv[gi & 3][qq] + acc[ai][bj][m][n] * scale;
                *(f32x4*)(out + o2) = o;
                if (xb) { u32x2 w; w.x = cvt_pk_bf16(o[0], o[1]); w.y = cvt_pk_bf16(o[2], o[3]); *(u32x2*)(xb + o2) = w; }
                q += (o[0] * o[0] + o[1] * o[1]) + (o[2] * o[2] + o[3] * o[3]);
            }
            if (xb) { q += __shfl_xor(q, 16); q += __shfl_xor(q, 32); if (fq == 0) ssq_add(sq + row0 + ai * HALF + m * 16, q); }
        }
#undef ER_LOAD
    }
};

struct EpiAny {
    static constexpr bool AFTER_DRAIN = false;
    int kind; bool perm; bf16_t* O; int ldc; const void* ss; float inv_k; void* p0; void* p1;
    __device__ __forceinline__ void operator()(const f32x4 (&acc)[2][2][4][2], const Unit& u, int wr, int wc, int fr, int fq) const {
        if (kind == 1) { EpiStore e{O, ldc, (const ssq_t*)ss, inv_k, (ssq_t*)p0, (ssq_t*)p1}; e(acc, u, wr, wc, fr, fq); }
        else if (kind == 2) { EpiSwiGLU e{O, ldc, (const ssq_t*)ss, inv_k}; e(acc, u, wr, wc, fr, fq); }
        else if (kind == 3) { EpiResid e{(const float*)ss, (float*)p0, O, (ssq_t*)p1, ldc, inv_k}; e(acc, u, wr, wc, fr, fq); }
        else { EpiLora e{O, ldc, (const float*)p0, (const float*)p1}; e(acc, u, wr, wc, fr, fq); }
    }
};
template <class Epi, class Sched, bool ALIGN_EPI = false, bool SP2 = false>
__device__ __forceinline__ void gemm_phase(PG8_LAS unsigned char* lds, const Gemm g, const Sched& S, const Epi& E, const int tid_in) {
    const int tid = tid_in, wid = __builtin_amdgcn_readfirstlane(tid >> 6), lane = tid & 63, wr = wid >> 2, wc = wid & 3, fr = lane & 15, fq = lane >> 4;
    const int K = g.K, nt = K / BK;
    unsigned voffA[2], voffB[2];
#pragma unroll
    for (int i = 0; i < 2; ++i) { int R, C; stage_rc(tid * 16 + i * 8192, R, C); const int Rb = E.perm ? ((R & ~31) + perm32(R & 31)) : R;
        voffA[i] = (unsigned)(R * g.lda + C) * 2u; voffB[i] = (unsigned)(Rb * K + C) * 2u; }
    const size_t kstep = (size_t)(BK * 2);
    const size_t hstep = (size_t)HALF * K * 2;
    const size_t tstep = 2 * hstep; const size_t hstepA = (size_t)HALF * g.lda * 2, tstepA = 2 * hstepA;
    const unsigned ldsw = (unsigned)wid * 1024u;
    const int aoff = lds_byte(wr * 64 + fr, fq * 8), boff = lds_byte(wc * 32 + fr, fq * 8);
#define PG8_SA(b, h) (((b) * 2 + (h)) * HTB)
#define PG8_SB(b, h) ((4 + (b) * 2 + (h)) * HTB)
#define PG8_STAGE(bufoff, gbase, voff) do { _Pragma("unroll") for (int _i = 0; _i < 2; ++_i) \
        __builtin_amdgcn_global_load_lds((const unsigned*)((const char*)(gbase) + (voff)[_i]), (PG8_LAS unsigned*)(lds + (bufoff) + ldsw + _i * 8192), 16, 0, 0); } while (0)
#define PG8_LDA(dst, b, h) do { _Pragma("unroll") for (int m = 0; m < 4; ++m) _Pragma("unroll") for (int k = 0; k < 2; ++k) dst[m][k] = *(const PG8_LAS bf16x8*)(lds + PG8_SA(b, h) + aoff + m * 2048 + k * 1024); } while (0)
#define PG8_LDB(dst, b, h) do { _Pragma("unroll") for (int n = 0; n < 2; ++n) _Pragma("unroll") for (int k = 0; k < 2; ++k) dst[n][k] = *(const PG8_LAS bf16x8*)(lds + PG8_SB(b, h) + boff + n * 2048 + k * 1024); } while (0)
#define PG8_MMA(ai, bj, At, Bt) do { __builtin_amdgcn_s_setprio(1); _Pragma("unroll") for (int m = 0; m < 4; ++m) _Pragma("unroll") for (int n = 0; n < 2; ++n) _Pragma("unroll") for (int k = 0; k < 2; ++k) \
        acc[ai][bj][m][n] = __builtin_amdgcn_mfma_f32_16x16x32_bf16(Bt[n][k], At[m][k], acc[ai][bj][m][n], 0, 0, 0); __builtin_amdgcn_s_setprio(0); } while (0)
#define PG8_WAIT_V(n) asm volatile("s_waitcnt vmcnt(" #n ")" ::: "memory")
#define PG8_WAIT_L(n) asm volatile("s_waitcnt lgkmcnt(" #n ")" ::: "memory")
#define PG8_BAR __builtin_amdgcn_s_barrier()
#define PG8_SCHED __builtin_amdgcn_sched_barrier(0)
    Unit cur, nxt; int ui = 0;
    if (!S.next(0, cur)) return;
    f32x4 acc[2][2][4][2];
#pragma unroll
    for (int a = 0; a < 2; ++a)
#pragma unroll
        for (int b = 0; b < 2; ++b)
#pragma unroll
            for (int m = 0; m < 4; ++m)
#pragma unroll
                for (int n = 0; n < 2; ++n) acc[a][b][m][n] = (f32x4){0.f, 0.f, 0.f, 0.f};
    bf16x8 At[4][2], B0[2][2], B1[2][2];
    const char* cA = (const char*)g.A + (size_t)cur.pm * tstepA; const char* cB = (const char*)g.Bt + (size_t)cur.pn * tstep;
    S.a_ready(cur);
    if constexpr (SP2) {
        PG8_STAGE(PG8_SB(0, 0), cB, voffB); PG8_STAGE(PG8_SB(0, 1), cB + hstep, voffB); PG8_STAGE(PG8_SA(0, 0), cA, voffA); PG8_STAGE(PG8_SA(0, 1), cA + hstepA, voffA);
        if (wr == 1) PG8_BAR;
        PG8_WAIT_V(2); PG8_BAR;
        PG8_STAGE(PG8_SB(1, 0), cB + kstep, voffB); PG8_STAGE(PG8_SA(1, 0), cA + kstep, voffA); PG8_STAGE(PG8_SB(1, 1), cB + hstep + kstep, voffB);
        PG8_WAIT_V(6); PG8_BAR;
    } else {
        PG8_STAGE(PG8_SB(0, 0), cB, voffB); PG8_STAGE(PG8_SA(0, 0), cA, voffA); PG8_STAGE(PG8_SB(0, 1), cB + hstep, voffB); PG8_STAGE(PG8_SA(0, 1), cA + hstepA, voffA);
        if (wr == 1) PG8_BAR;
        PG8_WAIT_V(4); PG8_BAR;
        PG8_STAGE(PG8_SB(1, 0), cB + kstep, voffB); PG8_STAGE(PG8_SA(1, 0), cA + kstep, voffA); PG8_STAGE(PG8_SB(1, 1), cB + hstep + kstep, voffB);
        PG8_WAIT_V(6); PG8_BAR;
    }
    for (;;) {
        const bool has_next = S.next(ui + 1, nxt);
        const char* nA = has_next ? (const char*)g.A + (size_t)nxt.pm * tstepA : cA; const char* nB = has_next ? (const char*)g.Bt + (size_t)nxt.pn * tstep : cB;
        for (int t = 0; t < nt; t += 2) {
            const bool last = (t == nt - 2);
            const char* a1 = cA + (size_t)(t + 1) * kstep;
            const char* a2 = last ? nA : cA + (size_t)(t + 2) * kstep; const char* b2 = last ? nB : cB + (size_t)(t + 2) * kstep;
            const char* a3 = a2 + kstep; const char* b3 = b2 + kstep;
            if (last && has_next) S.a_ready(nxt);
            if constexpr (SP2) {
            PG8_LDB(B0, 0, 0); PG8_LDB(B1, 0, 1); PG8_SCHED; PG8_LDA(At, 0, 0); PG8_STAGE(PG8_SA(1, 1), a1 + hstepA, voffA);
            PG8_WAIT_V(8); PG8_WAIT_L(0); PG8_BAR; PG8_MMA(0, 0, At, B0); PG8_MMA(0, 1, At, B1); PG8_BAR; PG8_SCHED;
            PG8_LDA(At, 0, 1); PG8_STAGE(PG8_SB(0, 0), b2, voffB); PG8_STAGE(PG8_SB(0, 1), b2 + hstep, voffB); PG8_STAGE(PG8_SA(0, 0), a2, voffA);
            PG8_WAIT_V(8); PG8_WAIT_L(0); PG8_BAR; PG8_MMA(1, 0, At, B0); PG8_MMA(1, 1, At, B1); PG8_BAR; PG8_SCHED;
            PG8_LDB(B0, 1, 0); PG8_LDB(B1, 1, 1); PG8_SCHED; PG8_LDA(At, 1, 0); PG8_STAGE(PG8_SA(0, 1), a2 + hstepA, voffA);
            PG8_WAIT_V(8); PG8_WAIT_L(0); PG8_BAR; PG8_MMA(0, 0, At, B0); PG8_MMA(0, 1, At, B1); PG8_BAR; PG8_SCHED;
            PG8_LDA(At, 1, 1); PG8_STAGE(PG8_SB(1, 0), b3, voffB); PG8_STAGE(PG8_SB(1, 1), b3 + hstep, voffB); PG8_STAGE(PG8_SA(1, 0), a3, voffA);
            PG8_WAIT_V(8); PG8_WAIT_L(0); PG8_BAR; PG8_MMA(1, 0, At, B0); PG8_MMA(1, 1, At, B1); PG8_BAR; PG8_SCHED;
            } else {
            PG8_LDB(B0, 0, 0); PG8_SCHED; PG8_LDA(At, 0, 0); PG8_STAGE(PG8_SA(1, 1), a1 + hstepA, voffA);
            PG8_WAIT_L(8); PG8_BAR; PG8_WAIT_L(0); PG8_MMA(0, 0, At, B0); PG8_BAR; PG8_SCHED;
            PG8_LDB(B1, 0, 1); PG8_STAGE(PG8_SB(0, 0), b2, voffB);
            PG8_BAR; PG8_WAIT_L(0); PG8_MMA(0, 1, At, B1); PG8_BAR;
            PG8_LDA(At, 0, 1); PG8_STAGE(PG8_SA(0, 0), a2, voffA);
            PG8_BAR; PG8_WAIT_L(0); PG8_MMA(1, 0, At, B0); PG8_BAR; PG8_SCHED;
            PG8_STAGE(PG8_SB(0, 1), b2 + hstep, voffB);
            PG8_WAIT_V(6); PG8_BAR; PG8_MMA(1, 1, At, B1); PG8_BAR;
            PG8_LDB(B0, 1, 0); PG8_SCHED; PG8_LDA(At, 1, 0); PG8_STAGE(PG8_SA(0, 1), a2 + hstepA, voffA);
            PG8_WAIT_L(8); PG8_BAR; PG8_WAIT_L(0); PG8_MMA(0, 0, At, B0); PG8_BAR; PG8_SCHED;
            PG8_LDB(B1, 1, 1); PG8_STAGE(PG8_SB(1, 0), b3, voffB);
            PG8_BAR; PG8_WAIT_L(0); PG8_MMA(0, 1, At, B1); PG8_BAR;
            PG8_LDA(At, 1, 1); PG8_STAGE(PG8_SA(1, 0), a3, voffA);
            PG8_BAR; PG8_WAIT_L(0); PG8_MMA(1, 0, At, B0); PG8_BAR; PG8_SCHED;
            PG8_STAGE(PG8_SB(1, 1), b3 + hstep, voffB);
            PG8_WAIT_V(6); PG8_BAR; PG8_MMA(1, 1, At, B1); PG8_BAR;
            }
        }
        if constexpr (ALIGN_EPI) { if (wr == 0) PG8_BAR; }
        if constexpr (!Epi::AFTER_DRAIN) { E(acc, cur, wr, wc, fr, fq); S.done(cur); }
        if (!has_next) break;
#pragma unroll
        for (int a = 0; a < 2; ++a)
#pragma unroll
            for (int b = 0; b < 2; ++b)
#pragma unroll
                for (int m = 0; m < 4; ++m)
#pragma unroll
                    for (int n = 0; n < 2; ++n) acc[a][b][m][n] = (f32x4){0.f, 0.f, 0.f, 0.f};
        cur = nxt; cA = nA; cB = nB; ++ui;
        if constexpr (ALIGN_EPI) { if (wr == 1) PG8_BAR; }
    }
    PG8_WAIT_V(0);
    if constexpr (!ALIGN_EPI) { if (wr == 0) PG8_BAR; }
    PG8_BAR;
    if constexpr (Epi::AFTER_DRAIN) { E.fused(acc, cur, wr, wc, fr, fq, lds, wid, lane); S.done(cur); }
#undef PG8_SA
#undef PG8_SB
#undef PG8_STAGE
#undef PG8_LDA
#undef PG8_LDB
#undef PG8_MMA
#undef PG8_WAIT_V
#undef PG8_WAIT_L
#undef PG8_BAR
#undef PG8_SCHED
}
}

#define LAS __attribute__((address_space(3)))
using pg8::bf16_t; using pg8::bf16x8; using pg8::f32x4; using pg8::u32x4; using pg8::u32x2; using pg8::f32x2; using pg8::cvt_pk_bf16; using pg8::ssq_t;
typedef float f32x16 __attribute__((ext_vector_type(16)));
typedef short s16x4 __attribute__((ext_vector_type(4)));
typedef short v4i16_t __attribute__((ext_vector_type(4)));

constexpr int NB = 8, SEQ = 2048, DM = 2048, MT = NB * SEQ, FF = 5632, MEML = 256;
constexpr int ABN = 4896, ABP = 5120, CDN = 3872, CDP = 4096;
constexpr float EPS = 1e-6f, LOG2E = 1.4426950408889634f;
constexpr float LAMBDA_INIT = 0.3555090675f;
constexpr int NPHASE = 26;
constexpr int NTHREADS = 512;
constexpr int LDS_BYTES = 147456;

constexpr size_t MiB = (size_t)1 << 20;
constexpr size_t WS_SS = 656 * MiB, WS_CS64 = 1 * MiB, WS_CS32 = 5 * MiB, WS_MEMB = 7 * MiB, WS_MEMKV = 15 * MiB, WS_MEMVT = 19 * MiB;
constexpr size_t WS_WGUA = 21 * MiB, WS_WDA = 65 * MiB, WS_WGUB = 87 * MiB, WS_WDB = 131 * MiB;
constexpr size_t WS_WABIN = 153 * MiB, WS_WABOUT = 173 * MiB, WS_WCDIN = 181 * MiB, WS_WCDOUT = 197 * MiB, WS_WUQ = 205 * MiB, WS_WUKV = 207 * MiB;
constexpr size_t WS_WMQ = 208 * MiB, WS_WMO = 212 * MiB, WS_WMKV = 216 * MiB, WS_WLORA = 220 * MiB;
constexpr size_t WS_XB = 224 * MiB, WS_BIG = 288 * MiB, WS_BAR = 658 * MiB, WS_WGUC = 659 * MiB, WS_WDC = 703 * MiB, WS_END = 725 * MiB;
constexpr size_t B_H = 0;
constexpr size_t B0_U = 0, B0_LIN = 160 * MiB, B0_LOUT = 176 * MiB, B0_VT = 272 * MiB, B0_Y = 280 * MiB;
constexpr size_t B1_U = 0, B1_Q = 128 * MiB, B1_KV = 176 * MiB, B1_VTM = 240 * MiB, B1_VTD = 272 * MiB, B1_Y = 304 * MiB;
constexpr size_t BM_Q = 0, BM_O = 16 * MiB;
enum { SS_A0 = 0, SS_B0, SS_C0, SS_D0, SS_A1, SS_B1, SS_C1, SS_D1, SS_CQ, SS_CKV, SS_MEM, SS_DUMMY, SS_N };

enum { I_X = 0, I_MEM, I_POS, I_F1N, I_F1G, I_F1U, I_F1D, I_MIXN, I_ABIN, I_ABOUT, I_SWAQN, I_SWAKN, I_SINKS, I_MU, I_W0, I_W2, I_A0, I_A2, I_G2, I_KK, I_KA, I_RK, I_GNG, I_GNB,
       I_CDIN, I_CDOUT, I_CQN, I_CKVN, I_WUQ, I_WUKV, I_QNOPEN, I_KNOPEN, I_QROPEN, I_KROPEN, I_DQN, I_DKN, I_LQ1, I_LK1, I_LQ2, I_LK2, I_SUBLN, I_MXN, I_MXWQ, I_MXQN, I_MXWO,
       I_MEMN, I_MEMWKV, I_MEMKN, I_F2N, I_F2G, I_F2U, I_F2D, N_IN };

struct Params { const float* in[N_IN]; float* out; unsigned char* ws; int ph_lo, ph_hi; };

__device__ __forceinline__ float bf2f(bf16_t v) { return __uint_as_float((unsigned)v << 16); }
__device__ __forceinline__ bf16_t f2bf(float f) { return (bf16_t)(cvt_pk_bf16(f, 0.f) & 0xffffu); }
__device__ __forceinline__ float wave_sum(float v) {
#pragma unroll
    for (int o = 1; o < 64; o <<= 1) v += __shfl_xor(v, o);
    return v;
}
__device__ __forceinline__ float fexp2(float x) { return __builtin_amdgcn_exp2f(x); }

__device__ __forceinline__ void conv_matrix(const float* W, int K, int N, const float* gain, bf16_t* WT, int Kd, int mode, int row_off, LAS float* scr, int lane, int gw, int NGW) {
    const int nblk = N / 32, items = nblk * (K / 64);
    for (int it = gw; it < items; it += NGW) {
        const int kb = it / nblk, nb = it % nblk, k0 = 64 * kb, n0 = 32 * nb;
        float wv[32];
#pragma unroll
        for (int i = 0; i < 32; ++i) wv[i] = W[(size_t)(k0 + 2 * i + (lane >> 5)) * N + n0 + (lane & 31)];
        if (gain) {
#pragma unroll
            for (int i = 0; i < 32; ++i) wv[i] *= gain[k0 + 2 * i + (lane >> 5)];
        }
#pragma unroll
        for (int i = 0; i < 32; ++i) scr[(2 * i + (lane >> 5)) * 33 + (lane & 31)] = wv[i];
        asm volatile("s_waitcnt lgkmcnt(0)" ::: "memory");
        const int c = lane & 7;
        const int rbase = mode == 0 ? row_off + n0 : ((n0 >> 7) * 256 + (n0 & 127) + (mode == 2 ? 128 : 0));
#pragma unroll
        for (int j = 0; j < 4; ++j) { const int n = (lane >> 3) + 8 * j; const LAS float* s = scr + (8 * c) * 33 + n;
            u32x4 o; o.x = cvt_pk_bf16(s[0 * 33], s[1 * 33]); o.y = cvt_pk_bf16(s[2 * 33], s[3 * 33]); o.z = cvt_pk_bf16(s[4 * 33], s[5 * 33]); o.w = cvt_pk_bf16(s[6 * 33], s[7 * 33]);
            *(u32x4*)(WT + (size_t)(rbase + n) * Kd + k0 + 8 * c) = o; }
        asm volatile("s_waitcnt lgkmcnt(0)" ::: "memory");
    }
}
__device__ __forceinline__ void conv_ffn(const LAS Params* PL, int L, int which  , LAS float* scr, int lane, int gw, int NGW) {
    const float* nrm = PL->in[which ? I_F2N : I_F1N] + (size_t)L * DM;
    const float* wg = PL->in[which ? I_F2G : I_F1G] + (size_t)L * DM * FF;
    const float* wu = PL->in[which ? I_F2U : I_F1U] + (size_t)L * DM * FF;
    const float* wd = PL->in[which ? I_F2D : I_F1D] + (size_t)L * FF * DM;
    bf16_t* gu = (bf16_t*)(PL->ws + (which ? (L ? WS_WGUC : WS_WGUB) : WS_WGUA)); bf16_t* dn = (bf16_t*)(PL->ws + (which ? (L ? WS_WDC : WS_WDB) : WS_WDA));
    conv_matrix(wg, DM, FF, nrm, gu, DM, 1, 0, scr, lane, gw, NGW);
    conv_matrix(wu, DM, FF, nrm, gu, DM, 2, 0, scr, lane, gw, NGW);
    conv_matrix(wd, FF, DM, nullptr, dn, FF, 0, 0, scr, lane, gw, NGW);
}
__device__ __forceinline__ void row_to_bf16(const float* xrow, bf16_t* orow, ssq_t* ssq, int lane) {
    const f32x4* xr = (const f32x4*)xrow + lane; float s = 0.f; f32x4 v[8];
#pragma unroll
    for (int j = 0; j < 8; ++j) { v[j] = xr[64 * j]; s += (v[j][0] * v[j][0] + v[j][1] * v[j][1]) + (v[j][2] * v[j][2] + v[j][3] * v[j][3]); }
    s = wave_sum(s);
    u32x2* o8 = (u32x2*)orow + lane;
#pragma unroll
    for (int j = 0; j < 8; ++j) { u32x2 w; w.x = cvt_pk_bf16(v[j][0], v[j][1]); w.y = cvt_pk_bf16(v[j][2], v[j][3]); o8[64 * j] = w; }
    if (lane == 0) *ssq = (ssq_t)(s * pg8::SSQ_SCALE + 0.5f);
}
__device__ __forceinline__ void vt_transpose(const bf16_t* src, int pitch, int col0, int hstride, int nh, int DVh, int Sk, bf16_t* dst, int lane, int gw, int NGW) {
    const int sblk = Sk / 64, items = NB * nh * sblk;
    for (int it = gw; it < items; it += NGW) {
        const int sb = it % sblk, hd = (it / sblk) % nh, b = it / (sblk * nh);
        const int s = sb * 64 + lane;
        const bf16_t* sp = src + (size_t)(b * Sk + s) * pitch + col0 + hd * hstride;
        bf16_t* dp = dst + (size_t)((b * nh + hd) * DVh) * Sk + s;
        for (int dc = 0; dc < DVh / 8; ++dc) {
            const bf16x8 v = *(const bf16x8*)(sp + dc * 8);
#pragma unroll
            for (int j = 0; j < 8; ++j) dp[(size_t)(dc * 8 + j) * Sk] = (bf16_t)v[j];
        }
    }
}
template <int N>
__device__ __forceinline__ void norm_rope_row(bf16_t* p, int hstride, int nheads, const float* g, const f32x2* cs, int lane) {
    constexpr int GL = N / 8, HPP = 64 / GL, HALFN = N / 2;
    const int j = lane % GL, hl = lane / GL;
    const f32x4 g0 = *(const f32x4*)(g + 4 * j), g1 = *(const f32x4*)(g + HALFN + 4 * j);
    f32x4 c01 = {1.f, 0.f, 1.f, 0.f}, c23 = {1.f, 0.f, 1.f, 0.f};
    if (cs) { c01 = *(const f32x4*)(cs + 4 * j); c23 = *(const f32x4*)(cs + 4 * j + 2); }
    for (int h0 = 0; h0 < nheads; h0 += HPP) {
        const int hd = h0 + hl; const bool act = hd < nheads;
        bf16_t* q = p + (size_t)hd * hstride + 4 * j;
        u32x2 w0 = {0u, 0u}, w1 = {0u, 0u};
        if (act) { w0 = *(const u32x2*)q; w1 = *(const u32x2*)(q + HALFN); }
        float x0[4] = {__uint_as_float(w0.x << 16), __uint_as_float(w0.x & 0xffff0000u), __uint_as_float(w0.y << 16), __uint_as_float(w0.y & 0xffff0000u)};
        float x1[4] = {__uint_as_float(w1.x << 16), __uint_as_float(w1.x & 0xffff0000u), __uint_as_float(w1.y << 16), __uint_as_float(w1.y & 0xffff0000u)};
        float ss = (x0[0] * x0[0] + x0[1] * x0[1]) + (x0[2] * x0[2] + x0[3] * x0[3]) + (x1[0] * x1[0] + x1[1] * x1[1]) + (x1[2] * x1[2] + x1[3] * x1[3]);
#pragma unroll
        for (int o = 1; o < GL; o <<= 1) ss += __shfl_xor(ss, o);
        const float rs = __builtin_amdgcn_rsqf(ss * (1.f / N) + EPS);
        float y0[4], y1[4];
#pragma unroll
        for (int e = 0; e < 4; ++e) {
            const float a = x0[e] * rs * g0[e], b = x1[e] * rs * g1[e];
            const float co = e < 2 ? c01[2 * e] : c23[2 * (e - 2)], si = e < 2 ? c01[2 * e + 1] : c23[2 * (e - 2) + 1];
            y0[e] = a * co - b * si; y1[e] = a * si + b * co;
        }
        if (act) { u32x2 o0, o1; o0.x = cvt_pk_bf16(y0[0], y0[1]); o0.y = cvt_pk_bf16(y0[2], y0[3]); o1.x = cvt_pk_bf16(y1[0], y1[1]); o1.y = cvt_pk_bf16(y1[2], y1[3]);
            *(u32x2*)q = o0; *(u32x2*)(q + HALFN) = o1; }
    }
}

struct AttSrc { const bf16_t* q; int qp; const bf16_t* ka; int kap; const bf16_t* kb; int kbp; const bf16_t* v; int vp; int SK; const f32x2* qcs; const float* qg2; };
__device__ __forceinline__ int crow(int r, int hi) { return (r & 3) + 8 * (r >> 2) + 4 * hi; }
#define MFMA32(a, b, c) __builtin_amdgcn_mfma_f32_32x32x16_bf16((a), (b), (c), 0, 0, 0)

template <int DK, int DV, int MODE>
__device__ __forceinline__ void attn_tile(const LAS unsigned char* Kl, const LAS unsigned char* Vl, const bf16x8 (&qf)[DK / 16], f32x16 (&o)[DV / 32], float& m, float& l,
                                          int t, int q0, int wid, int r, int h, int qrow, float c) {
    constexpr int KS = DK / 16, KSTR = DK * 2 + 16, VSTR = DV * 2 + 16;
        const int k0 = t * 64;
        if (MODE != 2) { const int qlo = q0 + wid * 32; if (k0 > qlo + 31 || (MODE == 1 && qlo - (k0 + 63) >= 128)) return; }
        f32x16 p0, p1;
#pragma unroll
        for (int i = 0; i < 16; ++i) { p0[i] = 0.f; p1[i] = 0.f; }
#pragma unroll
        for (int ks = 0; ks < KS; ++ks) {
            const bf16x8 a0 = *(const LAS bf16x8*)(Kl + r * KSTR + (16 * ks + 8 * h) * 2);
            const bf16x8 a1 = *(const LAS bf16x8*)(Kl + (r + 32) * KSTR + (16 * ks + 8 * h) * 2);
            p0 = MFMA32(a0, qf[ks], p0); p1 = MFMA32(a1, qf[ks], p1);
        }
        bool need_mask = false;
        if (MODE == 0) need_mask = (k0 + 63 > q0 + wid * 32);
        if (MODE == 1) need_mask = (k0 + 63 > q0 + wid * 32) || (q0 + wid * 32 + 31 - k0 >= 128);
        float mx = -INFINITY;
#pragma unroll
        for (int i = 0; i < 16; ++i) {
            float s0 = p0[i] * c, s1 = p1[i] * c;
            if (need_mask) {
                const int key0 = k0 + crow(i, h), key1 = key0 + 32;
                const bool v0 = (key0 <= qrow) && (MODE != 1 || qrow - key0 < 128);
                const bool v1 = (key1 <= qrow) && (MODE != 1 || qrow - key1 < 128);
                s0 = v0 ? s0 : -INFINITY; s1 = v1 ? s1 : -INFINITY;
            }
            p0[i] = s0; p1[i] = s1; mx = fmaxf(mx, fmaxf(s0, s1));
        }
        mx = fmaxf(mx, __shfl_xor(mx, 32));
        const float m_new = fmaxf(m, mx), m_use = (m_new == -INFINITY) ? 0.f : m_new;
        const float alpha = fexp2(m - m_use);
        float ls = 0.f;
#pragma unroll
        for (int i = 0; i < 16; ++i) { p0[i] = fexp2(p0[i] - m_use); p1[i] = fexp2(p1[i] - m_use); ls += p0[i] + p1[i]; }
        l = l * alpha + ls; m = m_new;
#pragma unroll
        for (int d = 0; d < DV / 32; ++d)
#pragma unroll
            for (int i = 0; i < 16; ++i) o[d][i] *= alpha;
        bf16x8 pb[4];
#pragma unroll
        for (int sx = 0; sx < 2; ++sx) {
            u32x4 w0, w1;
            w0.x = cvt_pk_bf16(p0[8 * sx + 0], p0[8 * sx + 1]); w0.y = cvt_pk_bf16(p0[8 * sx + 2], p0[8 * sx + 3]); w0.z = cvt_pk_bf16(p0[8 * sx + 4], p0[8 * sx + 5]); w0.w = cvt_pk_bf16(p0[8 * sx + 6], p0[8 * sx + 7]);
            w1.x = cvt_pk_bf16(p1[8 * sx + 0], p1[8 * sx + 1]); w1.y = cvt_pk_bf16(p1[8 * sx + 2], p1[8 * sx + 3]); w1.z = cvt_pk_bf16(p1[8 * sx + 4], p1[8 * sx + 5]); w1.w = cvt_pk_bf16(p1[8 * sx + 6], p1[8 * sx + 7]);
            pb[sx] = __builtin_bit_cast(bf16x8, w0); pb[2 + sx] = __builtin_bit_cast(bf16x8, w1);
        }
#pragma unroll
        for (int d = 0; d < DV / 32; ++d)
#pragma unroll
            for (int t4 = 0; t4 < 4; ++t4) {
                const LAS unsigned char* vp_ = Vl + (16 * t4 + 4 * h + ((r & 15) >> 2)) * VSTR + (32 * d + 16 * (r >> 4) + 4 * (r & 3)) * 2;
                const s16x4 lo = __builtin_bit_cast(s16x4, __builtin_amdgcn_ds_read_tr16_b64_v4i16((LAS v4i16_t*)vp_));
                const s16x4 hi = __builtin_bit_cast(s16x4, __builtin_amdgcn_ds_read_tr16_b64_v4i16((LAS v4i16_t*)(vp_ + 8 * VSTR)));
                const bf16x8 vf = __builtin_shufflevector(lo, hi, 0, 1, 2, 3, 4, 5, 6, 7);
                o[d] = MFMA32(vf, pb[t4], o[d]);
                if (DV > 64 && t4 == 3) __builtin_amdgcn_sched_barrier(0);
            }
}
template <int DKA, int DKB, int DV, int MODE  >
__device__ __forceinline__ void attn_unit(LAS unsigned char* lds, const AttSrc& s, int q0, float c, float sink_l2, const float* qg, f32x16 (&o)[DV / 32], const int tid) {
    constexpr int DK = DKA + DKB, KS = DK / 16, KSTR = DK * 2 + 16, VSTR = DV * 2 + 16, VCH = DV / 8, KBYTES = 64 * KSTR, VBYTES = 64 * VSTR, TB = KBYTES + VBYTES;
    constexpr int KCH = DK / 8, NKC = 64 * KCH, NKR = (NKC + NTHREADS - 1) / NTHREADS, NVR = DV * 8 / NTHREADS;
    const int lane = tid & 63, wid = tid >> 6, r = lane & 31, h = lane >> 5;
    const int qrow = q0 + wid * 32 + r;
    bf16x8 qf[KS];
#pragma unroll
    for (int ks = 0; ks < KS; ++ks) qf[ks] = *(const bf16x8*)(s.q + (size_t)qrow * s.qp + 16 * ks + 8 * h);
    if (MODE == 2) {
        float ssq = 0.f;
#pragma unroll
        for (int ks = 0; ks < KS; ++ks)
#pragma unroll
            for (int j = 0; j < 8; ++j) { const float f = bf2f((bf16_t)qf[ks][j]); ssq += f * f; }
        ssq += __shfl_xor(ssq, 32);
        const float rs = __builtin_amdgcn_rsqf(ssq / (float)DK + EPS);
#pragma unroll
        for (int ks = 0; ks < KS; ++ks)
#pragma unroll
            for (int j = 0; j < 8; ++j) qf[ks][j] = (short)f2bf(bf2f((bf16_t)qf[ks][j]) * rs * qg[16 * ks + 8 * h + j]);
    }
    if (MODE == 1) {
        float xq[4][8]; float ssq = 0.f;
#pragma unroll
        for (int ks = 0; ks < 4; ++ks)
#pragma unroll
            for (int j = 0; j < 8; ++j) { xq[ks][j] = bf2f((bf16_t)qf[ks][j]); ssq += xq[ks][j] * xq[ks][j]; }
        ssq += __shfl_xor(ssq, 32);
        const float rs = __builtin_amdgcn_rsqf(ssq * (1.f / 64.f) + EPS);
#pragma unroll
        for (int ks = 0; ks < 2; ++ks)
#pragma unroll
            for (int j = 0; j < 8; ++j) { const int cidx = 16 * ks + 8 * h + j;
                const float a = xq[ks][j] * rs * qg[cidx], bq = xq[ks + 2][j] * rs * qg[cidx + 32];
                const f32x2 t = s.qcs[(size_t)qrow * 32 + cidx];
                qf[ks][j] = (short)f2bf(a * t.x - bq * t.y); qf[ks + 2][j] = (short)f2bf(a * t.y + bq * t.x); }
    }
    if (MODE == 0 && DKB == 32) {
        float xn[4][8], xp[2][8]; float s1 = 0.f, s2 = 0.f;
#pragma unroll
        for (int ks = 0; ks < 4; ++ks)
#pragma unroll
            for (int j = 0; j < 8; ++j) { xn[ks][j] = bf2f((bf16_t)qf[ks][j]); s1 += xn[ks][j] * xn[ks][j]; }
#pragma unroll
        for (int ks = 0; ks < 2; ++ks)
#pragma unroll
            for (int j = 0; j < 8; ++j) { xp[ks][j] = bf2f((bf16_t)qf[4 + ks][j]); s2 += xp[ks][j] * xp[ks][j]; }
        s1 += __shfl_xor(s1, 32); s2 += __shfl_xor(s2, 32);
        const float r1 = __builtin_amdgcn_rsqf(s1 * (1.f / 64.f) + EPS), r2 = __builtin_amdgcn_rsqf(s2 * (1.f / 32.f) + EPS);
#pragma unroll
        for (int ks = 0; ks < 4; ++ks)
#pragma unroll
            for (int j = 0; j < 8; ++j) qf[ks][j] = (short)f2bf(xn[ks][j] * r1 * qg[16 * ks + 8 * h + j]);
#pragma unroll
        for (int j = 0; j < 8; ++j) { const int cidx = 8 * h + j;
            const float a = xp[0][j] * r2 * s.qg2[cidx], bq = xp[1][j] * r2 * s.qg2[cidx + 16];
            const f32x2 t = s.qcs[(size_t)qrow * 16 + cidx];
            qf[4][j] = (short)f2bf(a * t.x - bq * t.y); qf[5][j] = (short)f2bf(a * t.y + bq * t.x); }
    }
    const int t_lo = MODE == 1 ? (q0 >= 128 ? q0 / 64 - 2 : 0) : 0;
    const int t_hi = MODE == 2 ? s.SK / 64 : q0 / 64 + 4;
    float m = MODE == 1 ? sink_l2 : -INFINITY;
    float l = (MODE == 1 && h == 0) ? 1.f : 0.f;
#pragma unroll
    for (int d = 0; d < DV / 32; ++d)
#pragma unroll
        for (int i = 0; i < 16; ++i) o[d][i] = 0.f;
    constexpr bool PF2 = !(DV == 128 && MODE == 0);
    u32x4 krA[NKR], vrA[NVR], krB[PF2 ? NKR : 1], vrB[PF2 ? NVR : 1];
#define ATT_LOAD(KR, VR, t) do { const int k0_ = (t) * 64; \
        _Pragma("unroll") for (int i = 0; i < NKR; ++i) { const int cc = tid + NTHREADS * i; if (cc < NKC) { const int row = cc / KCH, ch = cc % KCH; \
            const bf16_t* sp = (ch < DKA / 8) ? s.ka + (size_t)(k0_ + row) * s.kap + ch * 8 : s.kb + (size_t)(k0_ + row) * s.kbp + (ch - DKA / 8) * 8; KR[i] = *(const u32x4*)sp; } } \
        _Pragma("unroll") for (int i = 0; i < NVR; ++i) { const int cc = tid + NTHREADS * i; const int key = cc / VCH, ch = cc % VCH; VR[i] = *(const u32x4*)(s.v + (size_t)(k0_ + key) * s.vp + ch * 8); } } while (0)
#define ATT_STORE(KR, VR, Kl, Vl) do { \
        _Pragma("unroll") for (int i = 0; i < NKR; ++i) { const int cc = tid + NTHREADS * i; if (cc < NKC) { const int row = cc / KCH, ch = cc % KCH; *(LAS u32x4*)((Kl) + row * KSTR + ch * 16) = KR[i]; } } \
        _Pragma("unroll") for (int i = 0; i < NVR; ++i) { const int cc = tid + NTHREADS * i; const int key = cc / VCH, ch = cc % VCH; *(LAS u32x4*)((Vl) + key * VSTR + ch * 16) = VR[i]; } } while (0)
    ATT_LOAD(krA, vrA, t_lo);
    if (PF2) { if (t_lo + 1 < t_hi) ATT_LOAD(krB, vrB, t_lo + 1); }
    constexpr int STEP = PF2 ? 2 : 1;
    for (int t = t_lo; t < t_hi; t += STEP) {
        {
            LAS unsigned char* Kl = lds + (PF2 ? 0 : ((t - t_lo) & 1)) * TB; LAS unsigned char* Vl = Kl + KBYTES;
            ATT_STORE(krA, vrA, Kl, Vl);
            __syncthreads();
            if (t + STEP < t_hi) ATT_LOAD(krA, vrA, t + STEP);
            attn_tile<DK, DV, MODE>(Kl, Vl, qf, o, m, l, t, q0, wid, r, h, qrow, c);
        }
        if (PF2) { if (t + 1 < t_hi) {
            LAS unsigned char* Kl = lds + TB; LAS unsigned char* Vl = Kl + KBYTES;
            ATT_STORE(krB, vrB, Kl, Vl);
            __syncthreads();
            if (t + 3 < t_hi) ATT_LOAD(krB, vrB, t + 3);
            attn_tile<DK, DV, MODE>(Kl, Vl, qf, o, m, l, t + 1, q0, wid, r, h, qrow, c);
        } }
    }
#undef ATT_LOAD
#undef ATT_STORE
    l += __shfl_xor(l, 32);
    const float inv = 1.f / l;
#pragma unroll
    for (int d = 0; d < DV / 32; ++d)
#pragma unroll
        for (int i = 0; i < 16; ++i) o[d][i] *= inv;
    __syncthreads();
}
template <int DV>
__device__ __forceinline__ void attn_store(const f32x16 (&o)[DV / 32], bf16_t* yrow, int h) {
#pragma unroll
    for (int d = 0; d < DV / 32; ++d)
#pragma unroll
        for (int p = 0; p < 2; ++p) {
            const int ie = 2 * p, io = 2 * p + 1;
            const unsigned x0 = cvt_pk_bf16(o[d][4 * ie], o[d][4 * ie + 1]), x1 = cvt_pk_bf16(o[d][4 * ie + 2], o[d][4 * ie + 3]);
            const unsigned y0 = cvt_pk_bf16(o[d][4 * io], o[d][4 * io + 1]), y1 = cvt_pk_bf16(o[d][4 * io + 2], o[d][4 * io + 3]);
            const auto r0 = __builtin_amdgcn_permlane32_swap(x0, y0, false, false);
            const auto r1 = __builtin_amdgcn_permlane32_swap(x1, y1, false, false);
            u32x4 w; w.x = r0[0]; w.y = r1[0]; w.z = r0[1]; w.w = r1[1];
            *(u32x4*)(yrow + 32 * d + 8 * (2 * p + h)) = w;
        }
}

constexpr int TC = 32;
#define DPP_ADD(v, ctrl) ((v) + __int_as_float(__builtin_amdgcn_update_dpp(0, __float_as_int(v), (ctrl), 0xF, 0xF, true)))
__device__ __forceinline__ float red8(float v) { v = DPP_ADD(v, 0xB1); v = DPP_ADD(v, 0x4E); v = DPP_ADD(v, 0x141); return v; }

__device__ __forceinline__ void rwkv_unit(LAS unsigned char* lds, const LAS Params* PL, int b, int h, const int tid) {
    const bf16_t* u = (const bf16_t*)(PL->ws + WS_BIG + B0_U); const bf16_t* lo = (const bf16_t*)(PL->ws + WS_BIG + B0_LOUT); bf16_t* y = (bf16_t*)(PL->ws + WS_BIG + B0_Y);
    LAS float* A = (LAS float*)lds;
    LAS float* Gb = A + 2 * TC * 384;
    LAS float* Yb = Gb + 2 * TC * 64;
    LAS float* BON = Yb + 2 * TC * 64;
    const int lane = tid & 63, wid = tid >> 6;
    constexpr int NC = SEQ / TC;
    if (wid < 4) {
        const int rg = tid >> 3, jg = tid & 7;
        f32x2 S[8];
#pragma unroll
        for (int j = 0; j < 8; ++j) S[j] = (f32x2){0.f, 0.f};
        __syncthreads();
        for (int chn = 0; chn < NC; ++chn) {
            const LAS float* Ab = A + (chn & 1) * TC * 384 + 8 * jg;
            const LAS float* Av = A + (chn & 1) * TC * 384 + 320 + rg;
            LAS float* Yc = Yb + (chn & 1) * TC * 64 + rg;
#define RW_LV(V, tl) do { const LAS float* a_ = Ab + (tl) * 384; V##d0 = *(const LAS f32x4*)(a_); V##d1 = *(const LAS f32x4*)(a_ + 4); V##n0 = *(const LAS f32x4*)(a_ + 64); V##n1 = *(const LAS f32x4*)(a_ + 68); \
                V##e0 = *(const LAS f32x4*)(a_ + 128); V##e1 = *(const LAS f32x4*)(a_ + 132); V##k0 = *(const LAS f32x4*)(a_ + 192); V##k1 = *(const LAS f32x4*)(a_ + 196); \
                V##r0 = *(const LAS f32x4*)(a_ + 256); V##r1 = *(const LAS f32x4*)(a_ + 260); V##va = Av[(tl) * 384]; V##vb = Av[(tl) * 384 + 32]; } while (0)
#define RW_ROW2(V, yo) do { \
                f32x2 accA = S[0] * (f32x2){V##n0[0], V##n0[1]}, accB = S[4] * (f32x2){V##n0[0], V##n0[1]}; \
                f32x2 acc2A = S[2] * (f32x2){V##n1[0], V##n1[1]}, acc2B = S[6] * (f32x2){V##n1[0], V##n1[1]}; \
                accA = S[1] * (f32x2){V##n0[2], V##n0[3]} + accA; accB = S[5] * (f32x2){V##n0[2], V##n0[3]} + accB; \
                acc2A = S[3] * (f32x2){V##n1[2], V##n1[3]} + acc2A; acc2B = S[7] * (f32x2){V##n1[2], V##n1[3]} + acc2B; \
                accA = accA + acc2A; accB = accB + acc2B; \
                float sA = accA.x + accA.y, sB = accB.x + accB.y; \
                sA = DPP_ADD(sA, 0xB1); sB = DPP_ADD(sB, 0xB1); sA = DPP_ADD(sA, 0x4E); sB = DPP_ADD(sB, 0x4E); sA = DPP_ADD(sA, 0x141); sB = DPP_ADD(sB, 0x141); \
                const f32x2 saA = {sA, sA}, saB = {sB, sB}, vA = {V##va, V##va}, vB = {V##vb, V##vb}; \
                const f32x2 e_0 = {V##e0[0], V##e0[1]}, e_1 = {V##e0[2], V##e0[3]}, e_2 = {V##e1[0], V##e1[1]}, e_3 = {V##e1[2], V##e1[3]}; \
                const f32x2 k_0 = {V##k0[0], V##k0[1]}, k_1 = {V##k0[2], V##k0[3]}, k_2 = {V##k1[0], V##k1[1]}, k_3 = {V##k1[2], V##k1[3]}; \
                const f32x2 d_0 = {V##d0[0], V##d0[1]}, d_1 = {V##d0[2], V##d0[3]}, d_2 = {V##d1[0], V##d1[1]}, d_3 = {V##d1[2], V##d1[3]}; \
                f32x2 tA0 = saA * e_0, tB0 = saB * e_0, tA1 = saA * e_1, tB1 = saB * e_1, tA2 = saA * e_2, tB2 = saB * e_2, tA3 = saA * e_3, tB3 = saB * e_3; \
                tA0 = vA * k_0 + tA0; tB0 = vB * k_0 + tB0; tA1 = vA * k_1 + tA1; tB1 = vB * k_1 + tB1; tA2 = vA * k_2 + tA2; tB2 = vB * k_2 + tB2; tA3 = vA * k_3 + tA3; tB3 = vB * k_3 + tB3; \
                S[0] = S[0] * d_0 + tA0; S[4] = S[4] * d_0 + tB0; S[1] = S[1] * d_1 + tA1; S[5] = S[5] * d_1 + tB1; S[2] = S[2] * d_2 + tA2; S[6] = S[6] * d_2 + tB2; S[3] = S[3] * d_3 + tA3; S[7] = S[7] * d_3 + tB3; \
                f32x2 yA = S[0] * (f32x2){V##r0[0], V##r0[1]}, yB = S[4] * (f32x2){V##r0[0], V##r0[1]}; \
                f32x2 y2A = S[2] * (f32x2){V##r1[0], V##r1[1]}, y2B = S[6] * (f32x2){V##r1[0], V##r1[1]}; \
                yA = S[1] * (f32x2){V##r0[2], V##r0[3]} + yA; yB = S[5] * (f32x2){V##r0[2], V##r0[3]} + yB; \
                y2A = S[3] * (f32x2){V##r1[2], V##r1[3]} + y2A; y2B = S[7] * (f32x2){V##r1[2], V##r1[3]} + y2B; \
                yA = yA + y2A; yB = yB + y2B; \
                float uA = yA.x + yA.y, uB = yB.x + yB.y; \
                uA = DPP_ADD(uA, 0xB1); uB = DPP_ADD(uB, 0xB1); uA = DPP_ADD(uA, 0x4E); uB = DPP_ADD(uB, 0x4E); uA = DPP_ADD(uA, 0x141); uB = DPP_ADD(uB, 0x141); \
                if (jg == 0) { Yc[yo] = uA; Yc[(yo) + 32] = uB; } } while (0)
            f32x4 Pd0, Pd1, Pn0, Pn1, Pe0, Pe1, Pk0, Pk1, Pr0, Pr1, Qd0, Qd1, Qn0, Qn1, Qe0, Qe1, Qk0, Qk1, Qr0, Qr1; float Pva, Pvb, Qva, Qvb;
            RW_LV(P, 0);
#pragma unroll 2
            for (int tl = 0; tl < TC; tl += 2) {
                RW_LV(Q, tl + 1);
                RW_ROW2(P, tl * 64);
                if (tl + 2 < TC) RW_LV(P, tl + 2);
                RW_ROW2(Q, (tl + 1) * 64);
            }
#undef RW_LV
#undef RW_ROW2
            __syncthreads();
        }
    } else {
        const int hw = wid - 4, tl = hw * 8 + (lane >> 3), c8 = 8 * (lane & 7), ch = 64 * h + c8;
        float mu_r[8], mu_k[8], mu_v[8], c_kk[8], c_ka[8], c_rk[8], c_gg[8], c_gb[8];
#pragma unroll
        for (int e = 0; e < 8; ++e) { mu_r[e] = PL->in[I_MU][ch + e]; mu_k[e] = PL->in[I_MU][1024 + ch + e]; mu_v[e] = PL->in[I_MU][2048 + ch + e];
            c_kk[e] = PL->in[I_KK][ch + e]; c_ka[e] = PL->in[I_KA][ch + e]; c_rk[e] = PL->in[I_RK][ch + e]; c_gg[e] = PL->in[I_GNG][ch + e]; c_gb[e] = PL->in[I_GNB][ch + e]; }
        bf16x8 pr, pk, pv, qr, qk, qv, pw, pa, pgt;
#define UNPK(v, e) bf2f((bf16_t)(v)[e])
#define RW_LOAD(chn) do { const int tg = (chn) * TC + tl; const size_t tok = (size_t)b * SEQ + tg; \
            const bf16_t* up = u + tok * ABP + 1536 + ch; pr = *(const bf16x8*)up; pk = *(const bf16x8*)(up + 1024); pv = *(const bf16x8*)(up + 2048); \
            if (tg > 0) { qr = *(const bf16x8*)(up - ABP); qk = *(const bf16x8*)(up + 1024 - ABP); qv = *(const bf16x8*)(up + 2048 - ABP); } \
            else { _Pragma("unroll") for (int e = 0; e < 8; ++e) { qr[e] = 0; qk[e] = 0; qv[e] = 0; } } \
            const bf16_t* lp = lo + tok * 3072 + ch; pw = *(const bf16x8*)lp; pa = *(const bf16x8*)(lp + 1024); pgt = *(const bf16x8*)(lp + 2048); } while (0)
#define RW_PREP(chn) do { LAS float* a_ = A + ((chn) & 1) * TC * 384 + tl * 384 + c8; LAS float* g_ = Gb + ((chn) & 1) * TC * 64 + tl * 64 + c8; LAS float* Bc = BON + ((chn) & 1) * TC; \
            float xr[8], kp[8], kkv[8], av[8], o0[8], o1[8], o2[8], o5[8], gg[8]; float s1 = 0.f, s2 = 0.f; \
            _Pragma("unroll") for (int e = 0; e < 8; ++e) { const float r0 = UNPK(pr, e), k0 = UNPK(pk, e), v0 = UNPK(pv, e); \
                xr[e] = r0 + (UNPK(qr, e) - r0) * mu_r[e]; const float xk = k0 + (UNPK(qk, e) - k0) * mu_k[e]; o5[e] = v0 + (UNPK(qv, e) - v0) * mu_v[e]; \
                av[e] = UNPK(pa, e); gg[e] = UNPK(pgt, e); o0[e] = fexp2(UNPK(pw, e) * LOG2E); \
                kkv[e] = xk * c_kk[e]; s1 += kkv[e] * kkv[e]; kp[e] = xk * (1.f + (av[e] - 1.f) * c_ka[e]); s2 += xr[e] * kp[e] * c_rk[e]; } \
            s1 = red8(s1); s2 = red8(s2); const float rn = 1.f / fmaxf(sqrtf(s1), 1e-12f); \
            _Pragma("unroll") for (int e = 0; e < 8; ++e) { const float kkn = kkv[e] * rn; o1[e] = -kkn; o2[e] = kkn * av[e]; } \
            *(LAS f32x4*)(a_) = (f32x4){o0[0], o0[1], o0[2], o0[3]}; *(LAS f32x4*)(a_ + 4) = (f32x4){o0[4], o0[5], o0[6], o0[7]}; \
            *(LAS f32x4*)(a_ + 64) = (f32x4){o1[0], o1[1], o1[2], o1[3]}; *(LAS f32x4*)(a_ + 68) = (f32x4){o1[4], o1[5], o1[6], o1[7]}; \
            *(LAS f32x4*)(a_ + 128) = (f32x4){o2[0], o2[1], o2[2], o2[3]}; *(LAS f32x4*)(a_ + 132) = (f32x4){o2[4], o2[5], o2[6], o2[7]}; \
            *(LAS f32x4*)(a_ + 192) = (f32x4){kp[0], kp[1], kp[2], kp[3]}; *(LAS f32x4*)(a_ + 196) = (f32x4){kp[4], kp[5], kp[6], kp[7]}; \
            *(LAS f32x4*)(a_ + 256) = (f32x4){xr[0], xr[1], xr[2], xr[3]}; *(LAS f32x4*)(a_ + 260) = (f32x4){xr[4], xr[5], xr[6], xr[7]}; \
            *(LAS f32x4*)(a_ + 320) = (f32x4){o5[0], o5[1], o5[2], o5[3]}; *(LAS f32x4*)(a_ + 324) = (f32x4){o5[4], o5[5], o5[6], o5[7]}; \
            *(LAS f32x4*)(g_) = (f32x4){gg[0], gg[1], gg[2], gg[3]}; *(LAS f32x4*)(g_ + 4) = (f32x4){gg[4], gg[5], gg[6], gg[7]}; \
            if ((lane & 7) == 0) Bc[tl] = s2; } while (0)
#define RW_POST(chn) do { const LAS float* a_ = A + ((chn) & 1) * TC * 384 + tl * 384 + 320 + c8; const LAS float* g_ = Gb + ((chn) & 1) * TC * 64 + tl * 64 + c8; \
            const LAS float* y_ = Yb + ((chn) & 1) * TC * 64 + tl * 64 + c8; const float bon = BON[((chn) & 1) * TC + tl]; \
            const f32x4 y0 = *(const LAS f32x4*)(y_), y1 = *(const LAS f32x4*)(y_ + 4), v0 = *(const LAS f32x4*)(a_), v1 = *(const LAS f32x4*)(a_ + 4), g0 = *(const LAS f32x4*)(g_), g1 = *(const LAS f32x4*)(g_ + 4); \
            float yy[8] = {y0[0], y0[1], y0[2], y0[3], y1[0], y1[1], y1[2], y1[3]}; const float vv[8] = {v0[0], v0[1], v0[2], v0[3], v1[0], v1[1], v1[2], v1[3]}; const float gq[8] = {g0[0], g0[1], g0[2], g0[3], g1[0], g1[1], g1[2], g1[3]}; \
            float sm = 0.f; _Pragma("unroll") for (int e = 0; e < 8; ++e) sm += yy[e]; const float mean = red8(sm) * (1.f / 64.f); \
            float sv = 0.f; _Pragma("unroll") for (int e = 0; e < 8; ++e) { yy[e] -= mean; sv += yy[e] * yy[e]; } const float rsd = __builtin_amdgcn_rsqf(red8(sv) * (1.f / 64.f) + 64e-5f); \
            float ov[8]; _Pragma("unroll") for (int e = 0; e < 8; ++e) ov[e] = (yy[e] * rsd * c_gg[e] + c_gb[e] + bon * vv[e]) * gq[e]; \
            u32x4 w; w.x = cvt_pk_bf16(ov[0], ov[1]); w.y = cvt_pk_bf16(ov[2], ov[3]); w.z = cvt_pk_bf16(ov[4], ov[5]); w.w = cvt_pk_bf16(ov[6], ov[7]); \
            *(u32x4*)(y + ((size_t)b * SEQ + (chn) * TC + tl) * DM + 1024 + ch) = w; } while (0)
        RW_LOAD(0); RW_PREP(0);
        __syncthreads();
        for (int chn = 0; chn < NC; ++chn) {
            if (chn + 1 < NC) RW_LOAD(chn + 1);
            if (chn > 0) RW_POST(chn - 1);
            if (chn + 1 < NC) RW_PREP(chn + 1);
            __syncthreads();
        }
        RW_POST(NC - 1);
#undef RW_LOAD
#undef RW_PREP
#undef RW_POST
#undef UNPK
    }
    __syncthreads();
}

#define XB_TMO      128
#define XB_XCNT(j)  (256  + 64 * (j))
#define XB_XSUB(j)  (1280 + 64 * (j))
#define XB_XGEN(j)  (2304 + 64 * (j))
#define XB_TOP      3328
#define XB_TOPGEN   3392
#define XCD_BAR_WORDS 3456
#define XB_SPIN_CAP (1u << 18)

__device__ __forceinline__ unsigned xb_ld(unsigned* p)              { return __hip_atomic_load(p, __ATOMIC_RELAXED, __HIP_MEMORY_SCOPE_AGENT); }
__device__ __forceinline__ unsigned xb_add(unsigned* p, unsigned v) { return __hip_atomic_fetch_add(p, v, __ATOMIC_RELAXED, __HIP_MEMORY_SCOPE_AGENT); }
__device__ __forceinline__ unsigned xb_xcc_id() { return (unsigned)__builtin_amdgcn_s_getreg((3 << 11) | 20) & 0xFu; }
#define XB_SPIN(cond, bar) do { unsigned _sp = 0; while (cond) { __builtin_amdgcn_s_sleep(1); \
    if ((++_sp & 255u) == 0u) { if (xb_ld(&(bar)[XB_TMO])) break; if (_sp > XB_SPIN_CAP) { atomicAdd(&(bar)[XB_TMO], 1u); break; } } } } while (0)

struct XcdBarrier {
    unsigned* bar; unsigned x;
    volatile LAS unsigned* st;
};

__device__ __forceinline__ XcdBarrier xcd_barrier_post(unsigned* bar, volatile LAS unsigned* st) {
    XcdBarrier b; b.bar = bar; b.x = xb_xcc_id(); b.st = st;
    if (threadIdx.x == 0) (void)xb_add(&bar[XB_XCNT(b.x)], 1u);
    return b;
}
__device__ __forceinline__ void xcd_barrier_complete(unsigned* bar, unsigned x, unsigned& nloc, unsigned& nx) {
    const unsigned G = gridDim.x * gridDim.y * gridDim.z;
    unsigned sum, cnt, mine, sp = 0u;
    for (;;) {
        sum = 0u; cnt = 0u; mine = 0u;
#pragma unroll
        for (unsigned j = 0; j < 16; ++j) { const unsigned c = xb_ld(&bar[XB_XCNT(j)]); sum += c; cnt += (c > 0u) ? 1u : 0u; mine = (j == x) ? c : mine; }
        if (sum == G) break;
        __builtin_amdgcn_s_sleep(1);
        if ((++sp & 255u) == 0u) { if (xb_ld(&bar[XB_TMO])) break; if (sp > XB_SPIN_CAP) { atomicAdd(&bar[XB_TMO], 1u); break; } }
    }
    nloc = mine > 0u ? mine : 1u; nx = cnt > 0u ? cnt : 1u;
}

__device__ __forceinline__ void xcd_barrier(const XcdBarrier& b) {
    asm volatile("s_waitcnt vmcnt(0)" ::: "memory");
    __syncthreads();
    if (threadIdx.x == 0) {
        unsigned* bar = b.bar;
        __builtin_amdgcn_s_waitcnt(0);
        unsigned nloc = b.st[0], nx = b.st[1];
        if (nloc == 0u) { xcd_barrier_complete(bar, b.x, nloc, nx); b.st[0] = nloc; b.st[1] = nx; }
        const unsigned old = xb_add(&bar[XB_XSUB(b.x)], 1u);
        const unsigned gen = old / nloc;
        if (old + 1u == (gen + 1u) * nloc) {
            __builtin_amdgcn_fence(__ATOMIC_RELEASE, "agent");
            asm volatile("s_waitcnt vmcnt(0)" ::: "memory");
            const unsigned og = xb_add(&bar[XB_TOP], 1u);
            const unsigned tg = og / nx;
            if (og + 1u == (tg + 1u) * nx) xb_add(&bar[XB_TOPGEN], 1u);
            else XB_SPIN(xb_ld(&bar[XB_TOPGEN]) == tg, bar);
            __builtin_amdgcn_fence(__ATOMIC_ACQUIRE, "agent");
            xb_add(&bar[XB_XGEN(b.x)], 1u);
            asm volatile("s_waitcnt vmcnt(0)" ::: "memory");
        } else {
            XB_SPIN(xb_ld(&bar[XB_XGEN(b.x)]) == gen, bar);
            __builtin_amdgcn_fence(__ATOMIC_ACQUIRE, "agent");
            asm volatile("s_waitcnt vmcnt(0)" ::: "memory");
        }
    }
    __syncthreads();
}

#ifndef EN_MASK
#define EN_MASK 0xFFFF
#endif
#define EN(b) ((EN_MASK >> (b)) & 1)
__global__ void __launch_bounds__(NTHREADS, 2) hybrid_fwd(Params P) {
    extern __shared__ __attribute__((aligned(16))) unsigned char lds_raw[];
    LAS unsigned char* lds = (LAS unsigned char*)lds_raw;
    cg::grid_group grid = cg::this_grid();
    const int tid0 = threadIdx.x, G0 = gridDim.x, bx0 = blockIdx.x;
    LAS Params* PLw = (LAS Params*)(lds + LDS_BYTES - 1024);
    for (int i = tid0; i < (int)(sizeof(Params) / 4); i += NTHREADS) ((LAS unsigned*)PLw)[i] = ((const unsigned*)&P)[i];
    __syncthreads();
    const LAS Params* PL = PLw;
    const int ph_lo = P.ph_lo, ph_hi = P.ph_hi;
    volatile LAS unsigned* bst = (volatile LAS unsigned*)(lds + LDS_BYTES - 1024 + 512);
    if (tid0 < 2) bst[tid0] = 0u;
    __syncthreads();
    XcdBarrier xbar = xcd_barrier_post((unsigned*)(P.ws + WS_BAR), bst);
#ifndef REP_MASK
#define REP_MASK 0
#endif
    unsigned rep_mask = REP_MASK; (void)rep_mask;
    for (int ph = ph_lo; ph < ph_hi; ++ph) {
#define ROOTS int tid = tid0, G = G0, bx = bx0; unsigned char* ws = P.ws; \
        asm volatile("" : "+v"(tid)); asm volatile("" : "+s"(G)); asm volatile("" : "+s"(bx)); asm volatile("" : "+s"(ws)); \
        const int lane = tid & 63, wave = __builtin_amdgcn_readfirstlane(tid >> 6); const int gw = bx * 8 + wave, NGW = G * 8; \
        ssq_t* ssb = (ssq_t*)(ws + WS_SS); f32x2* cs64 = (f32x2*)(ws + WS_CS64); f32x2* cs32 = (f32x2*)(ws + WS_CS32); bf16_t* xb = (bf16_t*)(ws + WS_XB); unsigned char* big = ws + WS_BIG; \
        (void)lane; (void)gw; (void)NGW; (void)ssb; (void)cs64; (void)cs32; (void)xb; (void)big;
        const int L = ph >= 14 ? 1 : 0;
        int kind = 0, nsub = 1;
        if (ph == 1 || ph == 4 || ph == 9 || ph == 16 || ph == 17 || ph == 21) kind = 1;
        if (ph == 2 || ph == 12 || ph == 14 || ph == 24) kind = 2;
        if (ph == 3 || ph == 8 || ph == 11 || ph == 13 || ph == 15 || ph == 20 || ph == 23 || ph == 25) kind = 3;
        if (ph == 6) kind = 4;
        if (ph == 17) nsub = 2;

        if (EN(0) && ph == 0) { ROOTS
            for (int i = bx * NTHREADS + tid; i < MT * 10; i += G * NTHREADS) { const int bsel = i / MT; const int bi = bsel < 9 ? 1 + bsel : SS_DUMMY; ssb[(size_t)bi * MT + (i % MT)] = 0u; }
            LAS float* scr = (LAS float*)(lds + wave * 16384);
            conv_ffn(PL, 0, 0, scr, lane, gw, NGW);
            conv_ffn(PL, 0, 1, scr, lane, gw, NGW);
            conv_matrix(PL->in[I_ABIN], DM, ABN, PL->in[I_MIXN], (bf16_t*)(ws + WS_WABIN), DM, 0, 0, scr, lane, gw, NGW);
            conv_matrix(PL->in[I_ABOUT], DM, DM, nullptr, (bf16_t*)(ws + WS_WABOUT), DM, 0, 0, scr, lane, gw, NGW);
            conv_matrix(PL->in[I_CDIN], DM, CDN, PL->in[I_MIXN] + DM, (bf16_t*)(ws + WS_WCDIN), DM, 0, 0, scr, lane, gw, NGW);
            conv_matrix(PL->in[I_CDOUT], DM, DM, nullptr, (bf16_t*)(ws + WS_WCDOUT), DM, 0, 0, scr, lane, gw, NGW);
            conv_matrix(PL->in[I_WUQ], 512, 1536, PL->in[I_CQN], (bf16_t*)(ws + WS_WUQ), 512, 0, 0, scr, lane, gw, NGW);
            conv_matrix(PL->in[I_WUKV], 256, 2048, PL->in[I_CKVN], (bf16_t*)(ws + WS_WUKV), 256, 0, 0, scr, lane, gw, NGW);
            for (int l2 = 0; l2 < 2; ++l2) {
                conv_matrix(PL->in[I_MXWQ] + (size_t)l2 * DM * 512, DM, 512, PL->in[I_MXN] + l2 * DM, (bf16_t*)(ws + WS_WMQ) + (size_t)l2 * 512 * DM, DM, 0, 0, scr, lane, gw, NGW);
                conv_matrix(PL->in[I_MXWO] + (size_t)l2 * 512 * DM, 512, DM, nullptr, (bf16_t*)(ws + WS_WMO) + (size_t)l2 * DM * 512, 512, 0, 0, scr, lane, gw, NGW);
            }
            conv_matrix(PL->in[I_MEMWKV], DM, 1024, PL->in[I_MEMN], (bf16_t*)(ws + WS_WMKV), DM, 0, 0, scr, lane, gw, NGW);
            { bf16_t* wl = (bf16_t*)(ws + WS_WLORA);
              for (int i = bx * NTHREADS + tid; i < 3072 * 512; i += G * NTHREADS) { const int n = i >> 9, k = i & 511; float v = 0.f;
                  if (n < 1024) { if (k < 64) v = PL->in[I_W2][k * 1024 + n]; }
                  else if (n < 2048) { if (k >= 128 && k < 192) v = PL->in[I_A2][(k - 128) * 1024 + n - 1024]; }
                  else { if (k >= 256 && k < 416) v = PL->in[I_G2][(k - 256) * 1024 + n - 2048]; }
                  wl[i] = f2bf(v); } }
            for (int row = gw; row < MT; row += NGW) row_to_bf16(PL->in[I_X] + (size_t)row * DM, xb + (size_t)row * DM, ssb + (size_t)SS_A0 * MT + row, lane);
            for (int row = gw; row < NB * MEML; row += NGW) row_to_bf16(PL->in[I_MEM] + (size_t)row * DM, (bf16_t*)(ws + WS_MEMB) + (size_t)row * DM, ssb + (size_t)SS_MEM * MT + row, lane);
            { const int* pos = (const int*)PL->in[I_POS];
              for (int i = bx * NTHREADS + tid; i < MT * 48; i += G * NTHREADS) { const int tok = i / 48, j = i % 48; const bool big64 = j < 32; const int fi = big64 ? j : j - 32;
                  const float e = big64 ? (float)(2 * fi) / 64.f : (float)(2 * fi) / 32.f;
                  const float inv = 1.0f / powf(10000.0f, e);
                  const float ang = (float)pos[tok] * inv;
                  const double rev = (double)ang * 0.15915494309189535; const float fr = (float)(rev - rint(rev));
                  const f32x2 t = {__builtin_amdgcn_cosf(fr), __builtin_amdgcn_sinf(fr)};
                  if (big64) cs64[(size_t)tok * 32 + fi] = t; else cs32[(size_t)tok * 16 + fi] = t; } }
        }
        if (EN(1) && ph == 2) { ROOTS
            bf16_t* mkv = (bf16_t*)(ws + WS_MEMKV);
            for (int it = gw; it < NB * MEML * 4; it += NGW) { const int row = it >> 2, hd = it & 3; bf16_t* p = mkv + (size_t)row * 1024 + hd * 128;
                const float x0 = bf2f(p[lane]), x1 = bf2f(p[64 + lane]); const float ss = wave_sum(x0 * x0 + x1 * x1); const float rs = __builtin_amdgcn_rsqf(ss / 128.f + EPS);
                p[lane] = f2bf(x0 * rs * PL->in[I_MEMKN][lane]); p[64 + lane] = f2bf(x1 * rs * PL->in[I_MEMKN][64 + lane]); }
            __syncthreads();
        }
        for (int sub = 0; sub < nsub; ++sub) {
            if (kind == 0) break;
            ROOTS
            pg8::Gemm g; pg8::EpiAny E; E.kind = kind; E.perm = (kind != 3); E.O = nullptr; E.ldc = 0; E.ss = nullptr; E.inv_k = 1.f / DM; E.p0 = nullptr; E.p1 = nullptr;
            if (kind == 1) {
                if (ph == 1) { g = {(const bf16_t*)(ws + WS_MEMB), (const bf16_t*)(ws + WS_WMKV), NB * MEML, 1024, DM, DM}; E.O = (bf16_t*)(ws + WS_MEMKV); E.ldc = 1024; E.ss = ssb + (size_t)SS_MEM * MT; }
                else if (ph == 4) { g = {xb, (const bf16_t*)(ws + WS_WABIN), MT, ABP, DM, DM}; E.O = (bf16_t*)(big + B0_U); E.ldc = ABP; E.ss = ssb + (size_t)SS_B0 * MT; }
                else if (ph == 16) { g = {xb, (const bf16_t*)(ws + WS_WCDIN), MT, CDP, DM, DM}; E.O = (bf16_t*)(big + B1_U); E.ldc = CDP; E.ss = ssb + (size_t)SS_B1 * MT; E.p0 = ssb + (size_t)SS_CQ * MT; E.p1 = ssb + (size_t)SS_CKV * MT; }
                else if (ph == 17 && sub == 0) { g = {(const bf16_t*)(big + B1_U), (const bf16_t*)(ws + WS_WUQ), MT, 1536, 512, CDP}; E.O = (bf16_t*)(big + B1_Q); E.ldc = 1536; E.ss = ssb + (size_t)SS_CQ * MT; E.inv_k = 1.f / 512.f; }
                else if (ph == 17) { g = {(const bf16_t*)(big + B1_U) + 512, (const bf16_t*)(ws + WS_WUKV), MT, 2048, 256, CDP}; E.O = (bf16_t*)(big + B1_KV); E.ldc = 2048; E.ss = ssb + (size_t)SS_CKV * MT; E.inv_k = 1.f / 256.f; }
                else { g = {xb, (const bf16_t*)(ws + WS_WMQ) + (size_t)L * 512 * DM, MT, 512, DM, DM}; E.O = (bf16_t*)(big + BM_Q); E.ldc = 512; E.ss = ssb + (size_t)(L ? SS_C1 : SS_C0) * MT; }
            } else if (kind == 2) {
                const bool second = (ph == 12 || ph == 24);
                g = {xb, (const bf16_t*)(ws + (ph == 24 ? WS_WGUC : second ? WS_WGUB : WS_WGUA)), MT, 2 * FF, DM, DM};
                E.O = (bf16_t*)(big + B_H); E.ldc = FF;
                E.ss = ssb + (size_t)(ph == 2 ? SS_A0 : ph == 12 ? SS_D0 : ph == 14 ? SS_A1 : SS_D1) * MT;
            } else if (kind == 3) {
                float* outp = PL->out;
                E.ss = outp; E.p0 = outp; E.O = xb; E.ldc = DM; E.inv_k = 1.f;
                if (ph == 3 || ph == 15) { g = {(const bf16_t*)(big + B_H), (const bf16_t*)(ws + WS_WDA), MT, DM, FF, FF}; E.inv_k = 0.5f; E.p1 = ssb + (size_t)(ph == 3 ? SS_B0 : SS_B1) * MT; if (ph == 3) E.ss = PL->in[I_X]; }
                else if (ph == 13 || ph == 25) { g = {(const bf16_t*)(big + B_H), (const bf16_t*)(ws + (ph == 25 ? WS_WDC : WS_WDB)), MT, DM, FF, FF}; E.inv_k = 0.5f; E.p1 = ssb + (size_t)(ph == 13 ? SS_A1 : SS_DUMMY) * MT; if (ph == 25) E.O = nullptr; }
                else if (ph == 8) { g = {(const bf16_t*)(big + B0_Y), (const bf16_t*)(ws + WS_WABOUT), MT, DM, DM, DM}; E.p1 = ssb + (size_t)SS_C0 * MT; }
                else if (ph == 20) { g = {(const bf16_t*)(big + B1_Y), (const bf16_t*)(ws + WS_WCDOUT), MT, DM, DM, DM}; E.p1 = ssb + (size_t)SS_C1 * MT; }
                else { g = {(const bf16_t*)(big + BM_O), (const bf16_t*)(ws + WS_WMO) + (size_t)L * DM * 512, MT, DM, 512, 512}; E.p1 = ssb + (size_t)(L ? SS_D1 : SS_D0) * MT; }
            } else {
                g = {(const bf16_t*)(big + B0_LIN), (const bf16_t*)(ws + WS_WLORA), MT, 3072, 512, 512};
                E.O = (bf16_t*)(big + B0_LOUT); E.ldc = 3072; E.p0 = (void*)PL->in[I_W0]; E.p1 = (void*)PL->in[I_A0];
            }
#if REP_MASK
            if (kind == 3 && ((rep_mask >> ph) & 1u)) { E.inv_k = 0.f; E.p1 = ssb + (size_t)SS_DUMMY * MT; }
#endif
            pg8::StaticOrder S; S.init(g.M, g.N, G, bx);
            pg8::gemm_phase<pg8::EpiAny, pg8::StaticOrder, true, true>(lds, g, S, E, tid);
        }
        if (EN(6) && ph == 5) { ROOTS
            bf16_t* u = (bf16_t*)(big + B0_U);
            for (int tok = gw; tok < MT; tok += NGW) { bf16_t* p = u + (size_t)tok * ABP; const f32x2* c64 = cs64 + (size_t)tok * 32;
                norm_rope_row<64>(p + 1024, 64, 4, PL->in[I_SWAKN], c64, lane); }
            { bf16_t* lin = (bf16_t*)(big + B0_LIN);
              int dcol, kindc = 0; const int s8 = 8 * lane;
              if (lane < 36) { dcol = s8 < 64 ? s8 : (s8 < 128 ? 128 + (s8 - 64) : 256 + (s8 - 128)); kindc = s8 < 64 ? 0 : (s8 < 128 ? 1 : 2); }
              else { const int pz = lane - 36; dcol = pz < 8 ? 64 + 8 * pz : (pz < 16 ? 192 + 8 * (pz - 8) : 416 + 8 * (pz - 16)); }
              float mu8[8];
#pragma unroll
              for (int e = 0; e < 8; ++e) mu8[e] = lane < 36 ? PL->in[I_MU][3072 + s8 + e] : 0.f;
              for (int tok = gw; tok < MT; tok += NGW) {
                  u32x4 w = {0u, 0u, 0u, 0u};
                  if (lane < 36) { const bf16_t* up = u + (size_t)tok * ABP + 4608 + s8; const bf16x8 pc = *(const bf16x8*)up; bf16x8 pp;
                      if ((tok % SEQ) != 0) pp = *(const bf16x8*)(up - ABP); else {
#pragma unroll
                          for (int e = 0; e < 8; ++e) pp[e] = 0; }
                      float v[8];
#pragma unroll
                      for (int e = 0; e < 8; ++e) { const float c0 = bf2f((bf16_t)pc[e]); const float xs = c0 + (bf2f((bf16_t)pp[e]) - c0) * mu8[e];
                          v[e] = kindc == 0 ? tanhf(xs) : (kindc == 1 ? xs : 1.f / (1.f + __expf(-xs))); }
                      w.x = cvt_pk_bf16(v[0], v[1]); w.y = cvt_pk_bf16(v[2], v[3]); w.z = cvt_pk_bf16(v[4], v[5]); w.w = cvt_pk_bf16(v[6], v[7]); }
                  *(u32x4*)(lin + (size_t)tok * 512 + dcol) = w; } }
        }
        if (EN(7) && ph == 7) { ROOTS
            const int nscan = G / 2;
            if (EN(8) && bx < nscan) { for (int un = bx; un < NB * 16; un += nscan) rwkv_unit(lds, PL, un >> 4, un & 15, tid); }
            else {
                const bf16_t* u = (const bf16_t*)(big + B0_U); bf16_t* y = (bf16_t*)(big + B0_Y);
                const int nsw = G - nscan; const int vsw = ((nsw & 7) == 0 && (nscan & 7) == 0) ? ((bx & 7) * (nsw >> 3) + ((bx - nscan) >> 3)) : (bx - nscan);
                for (int un = vsw; un < NB * 16 * 8; un += nsw) { const int qb = un & 7, hd = (un >> 3) & 15, b = un >> 7;
                    AttSrc s; s.q = u + (size_t)b * SEQ * ABP + hd * 64; s.qp = ABP; s.ka = u + (size_t)b * SEQ * ABP + 1024 + (hd >> 2) * 64; s.kap = ABP; s.kb = s.ka; s.kbp = ABP;
                    s.v = u + (size_t)b * SEQ * ABP + 1280 + (hd >> 2) * 64; s.vp = ABP; s.SK = SEQ;
                    f32x16 o[2];
                    s.qcs = cs64 + (size_t)b * SEQ * 32;
                    attn_unit<64, 0, 64, 1>(lds, s, qb * 256, 0.125f * LOG2E, PL->in[I_SINKS][hd] * LOG2E, PL->in[I_SWAQN], o, tid);
                    attn_store<64>(o, y + ((size_t)b * SEQ + qb * 256 + wave * 32 + (lane & 31)) * DM + hd * 64, lane >> 5); }
                const int gw2 = (bx - nscan) * 8 + wave, NGW2 = (G - nscan) * 8;
                conv_ffn(PL, 1, 0, (LAS float*)(lds + wave * 16384), lane, gw2, NGW2);
                conv_ffn(PL, 1, 1, (LAS float*)(lds + wave * 16384), lane, gw2, NGW2);
            }
        }
        if (EN(9) && (ph == 10 || ph == 22)) { ROOTS
            const bf16_t* mq = (const bf16_t*)(big + BM_Q); bf16_t* mo = (bf16_t*)(big + BM_O);
            const int vbm = (G & 7) == 0 ? ((bx & 7) * (G >> 3) + (bx >> 3)) : bx;
            for (int un = vbm; un < NB * 4 * 8; un += G) { const int qb = un & 7, hd = (un >> 3) & 3, b = un >> 5;
                AttSrc s; s.q = mq + (size_t)b * SEQ * 512 + hd * 128; s.qp = 512; s.ka = (const bf16_t*)(ws + WS_MEMKV) + (size_t)b * MEML * 1024 + hd * 128; s.kap = 1024; s.kb = s.ka; s.kbp = 1024;
                s.v = (const bf16_t*)(ws + WS_MEMKV) + (size_t)b * MEML * 1024 + 512 + hd * 128; s.vp = 1024; s.SK = MEML;
                f32x16 o[4];
                attn_unit<128, 0, 128, 2>(lds, s, qb * 256, 0.08838834764831845f * LOG2E, 0.f, PL->in[I_MXQN] + L * 128, o, tid);
                attn_store<128>(o, mo + ((size_t)b * SEQ + qb * 256 + wave * 32 + (lane & 31)) * 512 + hd * 128, lane >> 5); }
        }
        if (EN(10) && ph == 18) { ROOTS
            bf16_t* u = (bf16_t*)(big + B1_U); bf16_t* q = (bf16_t*)(big + B1_Q); bf16_t* kv = (bf16_t*)(big + B1_KV);
            for (int tok = gw; tok < MT; tok += NGW) { const f32x2* c64 = cs64 + (size_t)tok * 32; const f32x2* c32 = cs32 + (size_t)tok * 16;
                norm_rope_row<64>(kv + (size_t)tok * 2048, 128, 16, PL->in[I_KNOPEN], nullptr, lane);
                norm_rope_row<32>(u + (size_t)tok * CDP + 768, 32, 1, PL->in[I_KROPEN], c32, lane);
                norm_rope_row<64>(u + (size_t)tok * CDP + 800, 64, 16, PL->in[I_DQN], c64, lane);
                norm_rope_row<64>(u + (size_t)tok * CDP + 1824, 64, 16, PL->in[I_DKN], c64, lane); }
        }
        if (EN(11) && ph == 19) { ROOTS
            const bf16_t* u = (const bf16_t*)(big + B1_U); const bf16_t* q = (const bf16_t*)(big + B1_Q); const bf16_t* kv = (const bf16_t*)(big + B1_KV); bf16_t* y = (bf16_t*)(big + B1_Y);
            const int vb = (G & 7) == 0 ? ((bx & 7) * (G >> 3) + (bx >> 3)) : bx;
            for (int un = vb; un < NB * 16 * 8; un += G) {
                int bh, qb;
                if (G == 256) { const int i = un >> 8; bh = vb >> 1; const int base = (vb & 1) ? 1 : 0; qb = (i == 0) ? base : (i == 1) ? 7 - base : (i == 2) ? 3 - base : 4 + base; }
                else { bh = un >> 3; qb = un & 7; }
                const int b = bh >> 4, hd = bh & 15;
                AttSrc s; s.q = q + (size_t)b * SEQ * 1536 + hd * 96; s.qp = 1536; s.ka = kv + (size_t)b * SEQ * 2048 + hd * 128; s.kap = 2048; s.kb = u + (size_t)b * SEQ * CDP + 768; s.kbp = CDP;
                s.v = kv + (size_t)b * SEQ * 2048 + hd * 128 + 64; s.vp = 2048; s.SK = SEQ;
                f32x16 o[2];
                s.qcs = cs32 + (size_t)b * SEQ * 16; s.qg2 = PL->in[I_QROPEN];
                attn_unit<64, 32, 64, 0>(lds, s, qb * 256, 0.10206207261596577f * LOG2E, 0.f, PL->in[I_QNOPEN], o, tid);
                attn_store<64>(o, y + ((size_t)b * SEQ + qb * 256 + wave * 32 + (lane & 31)) * DM + hd * 64, lane >> 5);
            }
            const float lam = __expf(wave_sum(PL->in[I_LQ1][lane] * PL->in[I_LK1][lane])) - __expf(wave_sum(PL->in[I_LQ2][lane] * PL->in[I_LK2][lane])) + LAMBDA_INIT;
            if (EN(12)) for (int un = vb; un < NB * 8 * 8; un += G) {
                int bh, qb;
                if (G == 256) { const int i = un >> 8; bh = vb >> 2; qb = i == 0 ? (vb & 3) : 7 - (vb & 3); }
                else { bh = un >> 3; qb = un & 7; }
                const int b = bh >> 3, hd = bh & 7;
                AttSrc s; s.qp = CDP; s.kap = CDP; s.kbp = CDP; s.SK = SEQ; s.v = u + (size_t)b * SEQ * CDP + 2848 + hd * 128; s.vp = CDP;
                s.q = u + (size_t)b * SEQ * CDP + 800 + (2 * hd) * 64; s.ka = u + (size_t)b * SEQ * CDP + 1824 + (2 * hd) * 64; s.kb = s.ka;
                f32x16 o1[4];
                f32x4* stash = (f32x4*)(ws + WS_XB) + (size_t)bx * NTHREADS + tid;
                attn_unit<64, 0, 128, 0>(lds, s, qb * 256, 0.125f * LOG2E, 0.f, nullptr, o1, tid);
#pragma unroll
                for (int d = 0; d < 4; ++d)
#pragma unroll
                    for (int i4 = 0; i4 < 4; ++i4) stash[(size_t)(d * 4 + i4) * G * NTHREADS] = (f32x4){o1[d][4 * i4], o1[d][4 * i4 + 1], o1[d][4 * i4 + 2], o1[d][4 * i4 + 3]};
                s.q += 64; s.ka += 64; s.kb = s.ka;
                attn_unit<64, 0, 128, 0>(lds, s, qb * 256, 0.125f * LOG2E, 0.f, nullptr, o1, tid);
                float ssq = 0.f;
#pragma unroll
                for (int d = 0; d < 4; ++d)
#pragma unroll
                    for (int i4 = 0; i4 < 4; ++i4) { const f32x4 a = stash[(size_t)(d * 4 + i4) * G * NTHREADS];
#pragma unroll
                        for (int j = 0; j < 4; ++j) { const float v = a[j] - lam * o1[d][4 * i4 + j]; o1[d][4 * i4 + j] = v; ssq += v * v; }
                        if (i4 == 3) asm volatile("" ::: "memory"); }
                ssq += __shfl_xor(ssq, 32);
                const float rs = __builtin_amdgcn_rsqf(ssq / 128.f + EPS) * (1.f - LAMBDA_INIT);
                const int hh = lane >> 5;
                bf16_t* yrow = y + ((size_t)b * SEQ + qb * 256 + wave * 32 + (lane & 31)) * DM + 1024 + hd * 128;
#pragma unroll
                for (int d = 0; d < 4; ++d) {
#pragma unroll
                    for (int i4 = 0; i4 < 4; ++i4) {
                        const f32x4 g4 = *(const f32x4*)(PL->in[I_SUBLN] + 32 * d + 8 * i4 + 4 * hh);
                        u32x2 w; w.x = cvt_pk_bf16(o1[d][4 * i4] * rs * g4[0], o1[d][4 * i4 + 1] * rs * g4[1]); w.y = cvt_pk_bf16(o1[d][4 * i4 + 2] * rs * g4[2], o1[d][4 * i4 + 3] * rs * g4[3]);
                        *(u32x2*)(yrow + 32 * d + 8 * i4 + 4 * hh) = w;
                    }
                    asm volatile("" ::: "memory");
                }
            }
        }
#if REP_MASK
        if ((rep_mask >> ph) & 1u) { rep_mask &= ~(1u << ph); --ph; xcd_barrier(xbar); continue; }
#endif
        if (ph + 1 < ph_hi) { if (ph_hi > 1000) grid.sync(); else xcd_barrier(xbar); }
    }
}

#ifndef MK_PER_PHASE
#define MK_PER_PHASE 0
#endif
extern "C" void kernel_launch(void* const* d_in, const int* in_sizes, int n_in, void* d_out, int out_size, void* d_ws, size_t ws_size, hipStream_t stream) {
    static int grid = 0;
    if (grid == 0) {
        if (n_in != N_IN || out_size != MT * DM || ws_size < WS_END) { fprintf(stderr, "kernel_launch: unexpected problem (n_in %d, out %d, ws %zu, need %zu)\n", n_in, out_size, ws_size, (size_t)WS_END); grid = -1; return; }
        int dev = 0, cus = 0, per_cu = 0;
        hipGetDevice(&dev); hipDeviceGetAttribute(&cus, hipDeviceAttributeMultiprocessorCount, dev);
        if (hipFuncSetAttribute((const void*)hybrid_fwd, hipFuncAttributeMaxDynamicSharedMemorySize, LDS_BYTES) != hipSuccess) { fprintf(stderr, "kernel_launch: hipFuncSetAttribute failed\n"); grid = -1; return; }
        hipOccupancyMaxActiveBlocksPerMultiprocessor(&per_cu, (const void*)hybrid_fwd, NTHREADS, LDS_BYTES);
        (void)hipGetLastError();
        if (per_cu < 1) per_cu = 1;
        grid = cus;
        fprintf(stderr, "kernel_launch: %d CUs, occupancy %d per CU, grid %d, ws %zu\n", cus, per_cu, grid, ws_size);
    }
    if (grid < 0) return;
    (void)hipMemsetAsync((unsigned char*)d_ws + WS_BAR, 0, 16384, stream);
    Params p{};
    for (int i = 0; i < N_IN; ++i) p.in[i] = (const float*)d_in[i];
    p.out = (float*)d_out; p.ws = (unsigned char*)d_ws;
#if MK_PER_PHASE
    for (int ph = 0; ph < NPHASE; ++ph) { p.ph_lo = ph; p.ph_hi = ph + 1; hipLaunchKernelGGL(hybrid_fwd, dim3(grid), dim3(NTHREADS), LDS_BYTES, stream, p); }
#else
    p.ph_lo = 0; p.ph_hi = NPHASE;
    void* args[] = {&p};
    hipError_t e = hipLaunchCooperativeKernel((const void*)hybrid_fwd, dim3(grid), dim3(NTHREADS), args, LDS_BYTES, stream);
    if (e != hipSuccess) fprintf(stderr, "cooperative launch failed: %s (grid %d)\n", hipGetErrorString(e), grid);
#endif
}
```
